# Optimizing an MI355X kernel written in HIP

```python
import math
import jax, jax.numpy as jnp
from jax import lax
import numpy as np

D_MODEL = 1024
BATCH = 2
SEQ = 8192
DEPTH = 2

MEM_LEN = 256
GROUP_W = 512
D_MIX = 3 * GROUP_W
DA_HEADS = 4
DA_QK_DIM = GROUP_W // (2 * DA_HEADS)
DA_V_DIM = 2 * DA_QK_DIM
HY_CH = GROUP_W
HY_ORDER = 2
SHORT_K = 3
HF_EMB = 33
HF_BANDS = (HF_EMB - 1) // 2
HF_ORDER = 64
HF_OUT = HY_ORDER * 2 * HY_CH
HF_TARGET = 1e-2
HF_FAST = 0.3
HF_SLOW = 1.5
HF_GAIN = 0.03
MEM_HEADS = 4
MEM_HEAD_DIM = GROUP_W // MEM_HEADS
D_IN = 10 * GROUP_W
ROPE_THETA = 10000.0
Q_BLOCK = 128
EPS = 1e-6

kernel_name = "hymba_style_diffattn_hyena_memxattn"


def rms_norm(x, g):
    x32 = x.astype(jnp.float32)
    y = x32 * lax.rsqrt(jnp.mean(x32 * x32, axis=-1, keepdims=True) + EPS)
    return (y * g.astype(jnp.float32)).astype(x.dtype)


def rope_tables(seq_len, dim):
    pos = jnp.arange(seq_len, dtype=jnp.float32)
    inv_freq = ROPE_THETA ** (-jnp.arange(0, dim, 2, dtype=jnp.float32) / dim)
    ang = pos[:, None] * inv_freq[None, :]
    return jnp.cos(ang)[:, None, None, :], jnp.sin(ang)[:, None, None, :]


def apply_rope(x, cos, sin):
    x32 = x.astype(jnp.float32)
    x1, x2 = jnp.split(x32, 2, axis=-1)
    return jnp.concatenate([x1 * cos - x2 * sin, x2 * cos + x1 * sin], axis=-1).astype(x.dtype)


def diff_attention(q, k, v, lam):
    b, s, h, _, dk = q.shape
    dv = v.shape[-1]
    scale = dk ** -0.5
    kh = k.transpose(0, 2, 1, 3, 4)
    vh = v.transpose(0, 2, 1, 3)
    nb = s // Q_BLOCK
    qb = q.transpose(0, 2, 1, 3, 4).reshape(b, h, nb, Q_BLOCK, 2, dk).transpose(2, 0, 1, 3, 4, 5)

    def block(q_blk):
        scores = jnp.einsum('bhqtd,bhktd->tbhqk', q_blk, kh).astype(jnp.float32) * scale
        p = jax.nn.softmax(scores, axis=-1)
        a = p[0] - lam * p[1]
        return jnp.einsum('bhqk,bhkv->bhqv', a.astype(vh.dtype), vh)

    o = lax.map(block, qb)
    return o.transpose(1, 0, 3, 2, 4).reshape(b, s, h, dv)


def short_conv(u, w, bias):
    c = u.shape[-1]
    y = lax.conv_general_dilated(
        u, w[:, None, :].astype(u.dtype), window_strides=(1,),
        padding=((SHORT_K // 2, SHORT_K // 2),),
        dimension_numbers=('NWC', 'WIO', 'NWC'), feature_group_count=c)
    return y + bias.astype(u.dtype)


def hyena_filters(seq_len, w1, b1, w2, b2, w3, b3, w4, freq):
    t = jnp.linspace(0.0, 1.0, seq_len, dtype=jnp.float32)[:, None]
    w = 2.0 * math.pi * jnp.arange(seq_len, dtype=jnp.float32)[:, None] / seq_len
    f = jnp.linspace(1e-4, HF_BANDS - 1, HF_BANDS, dtype=jnp.float32)[None, :]
    z = jnp.concatenate([t, jnp.cos(f * w), -jnp.sin(f * w)], axis=-1)
    fr = freq.astype(jnp.float32)
    hdn = jnp.sin(fr * (z @ w1.astype(jnp.float32) + b1.astype(jnp.float32)))
    hdn = jnp.sin(fr * (hdn @ w2.astype(jnp.float32) + b2.astype(jnp.float32)))
    hdn = jnp.sin(fr * (hdn @ w3.astype(jnp.float32) + b3.astype(jnp.float32)))
    filt = (hdn @ w4.astype(jnp.float32)).reshape(seq_len, HY_ORDER, 2, HY_CH)
    max_decay = math.log(HF_TARGET) / HF_FAST
    min_decay = math.log(HF_TARGET) / HF_SLOW
    deltas = jnp.abs(jnp.linspace(min_decay, max_decay, HY_CH, dtype=jnp.float32))
    decay = jnp.stack([jnp.exp(-t * deltas), jnp.exp(-t * deltas[::-1])], axis=1)
    return filt * decay[:, None, :, :]


def bidir_fft_conv(u, h_fwd, h_bwd, d_skip):
    seq_len, c = u.shape[1], u.shape[2]
    n_fft = 2 * seq_len
    kc = jnp.concatenate([h_fwd, jnp.zeros((1, c), jnp.float32), h_bwd[:seq_len - 1][::-1]], axis=0)
    k_f = jnp.fft.rfft(kc, n=n_fft, axis=0)
    u32 = u.astype(jnp.float32)
    u_f = jnp.fft.rfft(u32, n=n_fft, axis=1)
    y = jnp.fft.irfft(u_f * k_f[None], n=n_fft, axis=1)[:, :seq_len]
    return (y + u32 * d_skip.astype(jnp.float32)).astype(u.dtype)


def hybrid_layer(x, mem, layer_idx, cos, sin, g_norm, w_in, lq1, lk1, lq2, lk2, g_sub,
                 conv_w, conv_b, hf_w1, hf_b1, hf_w2, hf_b2, hf_w3, hf_b3, hf_w4, hf_freq,
                 hy_skip, g_mem, w_mem_kv, w_out):
    b, s, _ = x.shape
    h = rms_norm(x, g_norm)
    proj = h @ w_in
    gw = GROUP_W
    da_q, da_k, da_v, da_g, hy_u, hy_g, m_q, m_g = jnp.split(
        proj, [gw, 2 * gw, 3 * gw, 4 * gw, 7 * gw, 8 * gw, 9 * gw], axis=-1)

    q = apply_rope(da_q.reshape(b, s, DA_HEADS, 2, DA_QK_DIM), cos, sin)
    k = apply_rope(da_k.reshape(b, s, DA_HEADS, 2, DA_QK_DIM), cos, sin)
    v = da_v.reshape(b, s, DA_HEADS, DA_V_DIM)
    lam_init = 0.8 - 0.6 * math.exp(-0.3 * layer_idx)
    lam = (jnp.exp(jnp.sum(lq1.astype(jnp.float32) * lk1.astype(jnp.float32)))
           - jnp.exp(jnp.sum(lq2.astype(jnp.float32) * lk2.astype(jnp.float32))) + lam_init)
    o = diff_attention(q, k, v, lam)
    o = rms_norm(o, g_sub) * (1.0 - lam_init)
    y_a = o.reshape(b, s, gw) * jax.nn.silu(da_g)

    u = short_conv(hy_u, conv_w, conv_b)
    z, x1, x2 = jnp.split(u, 3, axis=-1)
    filt = hyena_filters(s, hf_w1, hf_b1, hf_w2, hf_b2, hf_w3, hf_b3, hf_w4, hf_freq)
    z = x1 * bidir_fft_conv(z, filt[:, 0, 0], filt[:, 0, 1], hy_skip[0])
    z = x2 * bidir_fft_conv(z, filt[:, 1, 0], filt[:, 1, 1], hy_skip[1])
    y_b = z * jax.nn.silu(hy_g)

    m = rms_norm(mem, g_mem)
    m_k, m_v = jnp.split(m @ w_mem_kv, 2, axis=-1)
    m_k = m_k.reshape(b, MEM_LEN, MEM_HEADS, MEM_HEAD_DIM)
    m_v = m_v.reshape(b, MEM_LEN, MEM_HEADS, MEM_HEAD_DIM)
    qm = m_q.reshape(b, s, MEM_HEADS, MEM_HEAD_DIM)
    sc = jnp.einsum('bshd,bmhd->bhsm', qm, m_k).astype(jnp.float32) * (MEM_HEAD_DIM ** -0.5)
    pm = jax.nn.softmax(sc, axis=-1)
    om = jnp.einsum('bhsm,bmhd->bshd', pm.astype(m_v.dtype), m_v).reshape(b, s, gw)
    y_c = om * jax.nn.silu(m_g)

    y = jnp.concatenate([y_a, y_b, y_c], axis=-1) @ w_out
    return x + y


def setup_inputs(seed: int = 0) -> dict:
    key = jax.random.key(seed)
    ks = jax.random.split(key, 26)
    f32 = jnp.float32

    def nrm(k, shape, scale):
        return jax.random.normal(k, shape, f32) * scale

    return {
        "x": nrm(ks[0], (BATCH, SEQ, D_MODEL), 1.0),
        "mem": nrm(ks[1], (BATCH, MEM_LEN, D_MODEL), 1.0),
        "g_norm": 1.0 + nrm(ks[2], (DEPTH, D_MODEL), 0.01),
        "w_in": nrm(ks[3], (DEPTH, D_MODEL, D_IN), D_MODEL ** -0.5),
        "da_lam_q1": nrm(ks[4], (DEPTH, DA_QK_DIM), 0.1),
        "da_lam_k1": nrm(ks[5], (DEPTH, DA_QK_DIM), 0.1),
        "da_lam_q2": nrm(ks[6], (DEPTH, DA_QK_DIM), 0.1),
        "da_lam_k2": nrm(ks[7], (DEPTH, DA_QK_DIM), 0.1),
        "da_subln_g": 1.0 + nrm(ks[8], (DEPTH, DA_V_DIM), 0.01),
        "hy_conv_w": nrm(ks[9], (DEPTH, SHORT_K, 3 * HY_CH), SHORT_K ** -0.5),
        "hy_conv_b": nrm(ks[10], (DEPTH, 3 * HY_CH), 0.02),
        "hf_w1": nrm(ks[11], (DEPTH, HF_EMB, HF_ORDER), HF_EMB ** -0.5),
        "hf_b1": nrm(ks[12], (DEPTH, HF_ORDER), 0.02),
        "hf_w2": nrm(ks[13], (DEPTH, HF_ORDER, HF_ORDER), HF_ORDER ** -0.5),
        "hf_b2": nrm(ks[14], (DEPTH, HF_ORDER), 0.02),
        "hf_w3": nrm(ks[15], (DEPTH, HF_ORDER, HF_ORDER), HF_ORDER ** -0.5),
        "hf_b3": nrm(ks[16], (DEPTH, HF_ORDER), 0.02),
        "hf_w4": nrm(ks[17], (DEPTH, HF_ORDER, HF_OUT), HF_GAIN * HF_ORDER ** -0.5),
        "hf_freq": 1.0 + nrm(ks[18], (DEPTH, HF_ORDER), 0.01),
        "hy_skip": nrm(ks[19], (DEPTH, HY_ORDER, HY_CH), 0.1),
        "g_mem": 1.0 + nrm(ks[20], (DEPTH, D_MODEL), 0.01),
        "w_mem_kv": nrm(ks[21], (DEPTH, D_MODEL, 2 * GROUP_W), D_MODEL ** -0.5),
        "w_out": nrm(ks[22], (DEPTH, D_MIX, D_MODEL), D_MIX ** -0.5),
        "g_final": 1.0 + nrm(ks[23], (D_MODEL,), 0.01),
    }


def reference(x, mem, g_norm, w_in, da_lam_q1, da_lam_k1, da_lam_q2, da_lam_k2, da_subln_g,
              hy_conv_w, hy_conv_b, hf_w1, hf_b1, hf_w2, hf_b2, hf_w3, hf_b3, hf_w4, hf_freq,
              hy_skip, g_mem, w_mem_kv, w_out, g_final):
    cos, sin = rope_tables(x.shape[1], DA_QK_DIM)
    for l in range(DEPTH):
        x = hybrid_layer(
            x, mem, l, cos, sin, g_norm[l], w_in[l],
            da_lam_q1[l], da_lam_k1[l], da_lam_q2[l], da_lam_k2[l], da_subln_g[l],
            hy_conv_w[l], hy_conv_b[l], hf_w1[l], hf_b1[l], hf_w2[l], hf_b2[l],
            hf_w3[l], hf_b3[l], hf_w4[l], hf_freq[l], hy_skip[l],
            g_mem[l], w_mem_kv[l], w_out[l])
    return rms_norm(x, g_final)
```

```cpp
#include <hip/hip_runtime.h>
#include <hip/hip_bf16.h>
#include <hip/hip_cooperative_groups.h>
#include <cstdio>
#include <cstdint>
namespace cg = cooperative_groups;

typedef unsigned short u16;
using bf16x8 = __attribute__((ext_vector_type(8))) short;
using s16x4  = __attribute__((ext_vector_type(4))) short;
using f32x16 = __attribute__((ext_vector_type(16))) float;
using f32x4  = __attribute__((ext_vector_type(4))) float;
using u32x4  = __attribute__((ext_vector_type(4))) unsigned;
using u32x2  = __attribute__((ext_vector_type(2))) unsigned;

constexpr int DM = 1024, NB = 2, SEQ = 8192, NTOK = NB * SEQ, DEPTH = 2;
constexpr int GW = 512, DIN = 5120, DMIX = 1536, MEML = 256;
constexpr float EPS = 1e-6f;
constexpr int NPHASE = 11;
#define REP_HY 1
#define REP_OUT0 1
#define REP_CROSS 1
#define REP_NORM0 1
#define REP_ATT 1
#define REP_PROJ 1
#define REP_PREP 1
#ifndef ONE_LAUNCH
#define ONE_LAUNCH 1
#endif
#define MEGA mega<(ONE_LAUNCH != 0)>
#define MEGA mega<(ONE_LAUNCH != 0)>
#ifndef DBG_SKIP_MIX
#define DBG_SKIP_MIX 0
#endif
#ifndef DBG_NPH
#define DBG_NPH 11
#endif
#ifndef DBG_KT_LO
#define DBG_KT_LO 0
#endif
#ifndef DBG_KT_HI
#define DBG_KT_HI 24
#endif
constexpr int LDS_BYTES = 131072 + 1024;

struct Params {
  const float *x, *mem, *g_norm, *w_in, *lq1, *lk1, *lq2, *lk2, *g_sub, *conv_w, *conv_b;
  const float *hf_w1, *hf_b1, *hf_w2, *hf_b2, *hf_w3, *hf_b3, *hf_w4, *hf_freq, *hy_skip, *g_mem, *w_mem_kv, *w_out, *g_final;
  float* out;
  char* ws;
  int phase_lo, phase_hi;
#define WSF(name, type, mib) __device__ __forceinline__ type* name() const { return (type*)(ws + (size_t)(mib) * 1048576); }
  WSF(Qp, u16, 0) WSF(Kp, u16, 16) WSF(Vp, u16, 32) WSF(GAp, u16, 48) WSF(MQp, u16, 64) WSF(MGp, u16, 80) WSF(HYTp, u16, 96)
  WSF(Hp, u16, 160) WSF(YBp, u16, 160) WSF(YAp, u16, 176) WSF(WinTp, u16, 192) WSF(WoutTp, u16, 212) WSF(WmTp, u16, 218) WSF(Mnp, u16, 222) WSF(MemKVp, u16, 224)
  WSF(hdnp, float, 226) WSF(ropeCp, float, 230) WSF(ropeSp, float, 231)
#undef WSF
};

#define SBAR() __builtin_amdgcn_sched_barrier(0)
__device__ __forceinline__ int crow(int r, int hi) { return (r & 3) + 8 * (r >> 2) + 4 * hi; }
typedef __bf16 bf2_t __attribute__((ext_vector_type(2)));
typedef float fl2_t __attribute__((ext_vector_type(2)));
__device__ __forceinline__ unsigned cvtpk(float lo, float hi) {
  fl2_t f = {lo, hi};
  bf2_t b = __builtin_convertvector(f, bf2_t);
  return __builtin_bit_cast(unsigned, b);
}
__device__ __forceinline__ u16 f2bf(float x) { return __builtin_bit_cast(u16, (__bf16)x); }
__device__ __forceinline__ float bf2f(u16 v) { return __uint_as_float(((unsigned)v) << 16); }
__device__ __forceinline__ float silu(float x) { return x / (1.f + __expf(-x)); }
__device__ __forceinline__ float wave_sum(float v) {
  for (int m = 32; m >= 1; m >>= 1) v += __shfl_xor(v, m);
  return v;
}

__device__ __forceinline__ void transpose_tile(const float* __restrict__ W, u16* __restrict__ WT, int Kd, int Nd, int tk, int tn, char* lds, int TIDX) {
  u16* tile = (u16*)lds;
  const int tid = TIDX;
  const int kr = tid >> 4, nc = (tid & 15) * 4;
  __syncthreads();
#pragma unroll
  for (int i = 0; i < 2; ++i) {
    const int k = kr + 32 * i;
    const f32x4 v = *reinterpret_cast<const f32x4*>(W + (size_t)(tk * 64 + k) * Nd + tn * 64 + nc);
#pragma unroll
    for (int j = 0; j < 4; ++j) tile[(nc + j) * 72 + k] = f2bf(v[j]);
  }
  __syncthreads();
  const int n = tid >> 3, kc = (tid & 7) * 8;
  const u32x4 o = *reinterpret_cast<const u32x4*>(tile + n * 72 + kc);
  *reinterpret_cast<u32x4*>(WT + (size_t)(tn * 64 + n) * Kd + tk * 64 + kc) = o;
}

__device__ __forceinline__ void norm_row_bf16(const float* __restrict__ xr, const float* __restrict__ g, u16* __restrict__ o, int lane) {
  f32x4 v[4]; float ss = 0;
#pragma unroll
  for (int i = 0; i < 4; ++i) { v[i] = *reinterpret_cast<const f32x4*>(xr + i * 256 + lane * 4); ss += v[i][0] * v[i][0] + v[i][1] * v[i][1] + v[i][2] * v[i][2] + v[i][3] * v[i][3]; }
  ss = wave_sum(ss);
  const float rs = rsqrtf(ss * (1.f / 1024.f) + EPS);
#pragma unroll
  for (int i = 0; i < 4; ++i) {
    const f32x4 gg = *reinterpret_cast<const f32x4*>(g + i * 256 + lane * 4);
    u32x2 w = {cvtpk(v[i][0] * rs * gg[0], v[i][1] * rs * gg[1]), cvtpk(v[i][2] * rs * gg[2], v[i][3] * rs * gg[3])};
    *reinterpret_cast<u32x2*>(o + i * 256 + lane * 4) = w;
  }
}
__device__ __forceinline__ void norm_row_f32(float* __restrict__ xr, const float* __restrict__ g, int lane) {
  f32x4 v[4]; float ss = 0;
#pragma unroll
  for (int i = 0; i < 4; ++i) { v[i] = *reinterpret_cast<const f32x4*>(xr + i * 256 + lane * 4); ss += v[i][0] * v[i][0] + v[i][1] * v[i][1] + v[i][2] * v[i][2] + v[i][3] * v[i][3]; }
  ss = wave_sum(ss);
  const float rs = rsqrtf(ss * (1.f / 1024.f) + EPS);
#pragma unroll
  for (int i = 0; i < 4; ++i) {
    const f32x4 gg = *reinterpret_cast<const f32x4*>(g + i * 256 + lane * 4);
    f32x4 w = {v[i][0] * rs * gg[0], v[i][1] * rs * gg[1], v[i][2] * rs * gg[2], v[i][3] * rs * gg[3]};
    *reinterpret_cast<f32x4*>(xr + i * 256 + lane * 4) = w;
  }
}

__device__ __forceinline__ void phase_prep(const Params& P, char* lds, int TIDX, int BIDX) {
  const int tid = TIDX, wid = tid >> 6, lane = tid & 63;
  const int nb = gridDim.x, bid = BIDX;
  {
    constexpr int U_IN = (DIN / 512) * (DM / 32), U_OUT = (DM / 512) * (DMIX / 32), U_M = (DM / 512) * (DM / 32);
    constexpr int U_L = U_IN + U_OUT + U_M;
    for (int it = bid; it < DEPTH * U_L; it += nb) {
      const int l = it / U_L; int r = it % U_L;
      const float* W; u16* WT; int Kd, Nd;
      if (r < U_IN) { W = P.w_in + (size_t)l * DM * DIN; WT = P.WinTp() + (size_t)l * DIN * DM; Kd = DM; Nd = DIN; }
      else if (r < U_IN + U_OUT) { r -= U_IN; W = P.w_out + (size_t)l * DMIX * DM; WT = P.WoutTp() + (size_t)l * DM * DMIX; Kd = DMIX; Nd = DM; }
      else { r -= U_IN + U_OUT; W = P.w_mem_kv + (size_t)l * DM * DM; WT = P.WmTp() + (size_t)l * DM * DM; Kd = DM; Nd = DM; }
      const int nkb = Kd / 32, nblk = r / nkb, kb = r % nkb;
      const int n = nblk * 512 + tid, k0 = kb * 32;
      const float* src = W + (size_t)k0 * Nd + n;
      float v[32];
#pragma unroll
      for (int k = 0; k < 32; ++k) v[k] = src[(size_t)k * Nd];
      u16* dst = WT + (size_t)n * Kd + k0;
#pragma unroll
      for (int c = 0; c < 4; ++c) {
        u32x4 o = {cvtpk(v[c * 8 + 0], v[c * 8 + 1]), cvtpk(v[c * 8 + 2], v[c * 8 + 3]), cvtpk(v[c * 8 + 4], v[c * 8 + 5]), cvtpk(v[c * 8 + 6], v[c * 8 + 7])};
        *reinterpret_cast<u32x4*>(dst + c * 8) = o;
      }
    }
  }
  for (int it = bid; it < NTOK / 8; it += nb) { const int row = it * 8 + wid; norm_row_bf16(P.x + (size_t)row * DM, P.g_norm, P.Hp() + (size_t)row * DM, lane); }
  for (int it = bid; it < DEPTH * NB * MEML / 8; it += nb) {
    const int r = it * 8 + wid, l = r / (NB * MEML), row = r % (NB * MEML);
    norm_row_bf16(P.mem + (size_t)row * DM, P.g_mem + l * DM, P.Mnp() + (size_t)r * DM, lane);
  }
  for (int gg = bid * 8 + wid; gg < DEPTH * SEQ / 8; gg += nb * 8) {
    const int r0 = gg * 8, l = r0 / SEQ, t0 = r0 % SEQ;
    float zf[8];
#pragma unroll
    for (int r = 0; r < 8; ++r) {
      const int tt = t0 + r; float z = 0.f;
      if (lane == 0) z = (float)tt * (1.f / 8191.f);
      else if (lane < 33) {
        const int i = (lane - 1) & 15;
        const float f = 1e-4f + (float)i * ((15.f - 1e-4f) / 15.f);
        const float w = (6.283185307179586f * (float)tt) / 8192.f;
        z = (lane <= 16) ? cosf(f * w) : -sinf(f * w);
      }
      zf[r] = z;
    }
    const float fr = P.hf_freq[l * 64 + lane];
    float a[8], h[8];
    { const float b = P.hf_b1[l * 64 + lane];
#pragma unroll
      for (int r = 0; r < 8; ++r) a[r] = b; }
#pragma unroll 3
    for (int i = 0; i < 33; ++i) { const float w = P.hf_w1[(l * 33 + i) * 64 + lane];
#pragma unroll
      for (int r = 0; r < 8; ++r) a[r] += __int_as_float(__builtin_amdgcn_readlane(__float_as_int(zf[r]), i)) * w; }
#pragma unroll
    for (int r = 0; r < 8; ++r) h[r] = sinf(fr * a[r]);
    { const float b = P.hf_b2[l * 64 + lane];
#pragma unroll
      for (int r = 0; r < 8; ++r) a[r] = b; }
#pragma unroll 4
    for (int i = 0; i < 64; ++i) { const float w = P.hf_w2[(l * 64 + i) * 64 + lane];
#pragma unroll
      for (int r = 0; r < 8; ++r) a[r] += __int_as_float(__builtin_amdgcn_readlane(__float_as_int(h[r]), i)) * w; }
#pragma unroll
    for (int r = 0; r < 8; ++r) h[r] = sinf(fr * a[r]);
    { const float b = P.hf_b3[l * 64 + lane];
#pragma unroll
      for (int r = 0; r < 8; ++r) a[r] = b; }
#pragma unroll 4
    for (int i = 0; i < 64; ++i) { const float w = P.hf_w3[(l * 64 + i) * 64 + lane];
#pragma unroll
      for (int r = 0; r < 8; ++r) a[r] += __int_as_float(__builtin_amdgcn_readlane(__float_as_int(h[r]), i)) * w; }
    u16* o = reinterpret_cast<u16*>(P.hdnp()) + ((size_t)l * SEQ + t0) * 64 + lane;
#pragma unroll
    for (int r = 0; r < 8; ++r) o[r * 64] = f2bf(sinf(fr * a[r]));
  }
  for (int idx = bid * 512 + tid; idx < SEQ * 32; idx += nb * 512) {
    const int pos = idx >> 5, j = idx & 31;
    const float inv = powf(10000.f, -((float)(2 * j) / 64.f));
    const float ang = (float)pos * inv;
    P.ropeCp()[idx] = cosf(ang); P.ropeSp()[idx] = sinf(ang);
  }
}

__device__ __forceinline__ int g_lds_off(int row, int ch) { return row * 128 + ((ch ^ ((row >> 1) & 7)) << 4); }

template <int MODE>
__device__ __forceinline__ void gemm_tile(const Params& P, int layer, int m0, int n0, char* lds, int TIDX, bool preloaded = false, int nm0 = -1, int nn0 = 0) {
  int tid = TIDX; asm volatile("" : "+v"(tid));
  const int wid = tid >> 6, lane = tid & 63, r32 = lane & 31, hi = lane >> 5;
  const int wm = wid >> 2, wn = wid & 3;
  constexpr int K = (MODE == 1) ? DMIX : DM;
  constexpr int NK = K / 64;
  const u16* Bt = (MODE == 0) ? P.WinTp() + (size_t)layer * DIN * DM : (MODE == 1) ? P.WoutTp() + (size_t)layer * DM * DMIX : P.WmTp() + (size_t)layer * DM * DM;
  const int srow = tid >> 3, sch = tid & 7;
  f32x16 acc[4][2];
#pragma unroll
  for (int a = 0; a < 4; ++a)
#pragma unroll
    for (int b = 0; b < 2; ++b) acc[a][b] = f32x16{};
  u32x4 ra[4], rb[4];
  auto a_ptr = [&](int kt, int mm) -> const u16* {
    if (MODE == 0) return P.Hp() + (size_t)mm * DM + kt * 64;
    if (MODE == 2) return P.Mnp() + ((size_t)layer * NB * MEML + mm) * DM + kt * 64;
    const int src = kt >> 3, ko = (kt & 7) * 64;
    const u16* b = (src == 0) ? P.YAp() : (src == 1) ? P.YBp() : P.GAp();
    return b + (size_t)mm * GW + ko;
  };
  constexpr int LDA = (MODE == 1) ? GW : DM;
#define G_LOAD_AT(kt, mm, nn) do { const u16* ap = a_ptr(kt, mm); const u16* bp = Bt + (size_t)(nn) * K + (kt) * 64;                       \
    _Pragma("unroll") for (int i = 0; i < 4; ++i) {                                                                      \
      ra[i] = *reinterpret_cast<const u32x4*>(ap + (size_t)(srow + i * 64) * LDA + sch * 8);                            \
      rb[i] = *reinterpret_cast<const u32x4*>(bp + (size_t)(srow + i * 64) * K + sch * 8); } } while (0)
#define G_WRITE(buf) do { char* la = lds + (buf) * 65536; char* lb = la + 32768;                                          \
    _Pragma("unroll") for (int i = 0; i < 4; ++i) {                                                                      \
      *reinterpret_cast<u32x4*>(la + g_lds_off(srow + i * 64, sch)) = ra[i];                                             \
      *reinterpret_cast<u32x4*>(lb + g_lds_off(srow + i * 64, sch)) = rb[i]; } } while (0)
#define G_LOAD(kt) G_LOAD_AT(kt, m0, n0)
  constexpr int KT0 = 0, KT1 = NK;
  if (!preloaded) { __syncthreads(); G_LOAD(KT0); G_WRITE(KT0 & 1); }
  __syncthreads();
  for (int kt = KT0; kt < KT1; ++kt) {
    if (kt + 1 < KT1) G_LOAD(kt + 1);
    const char* la = lds + (kt & 1) * 65536; const char* lb = la + 32768;
#pragma unroll
    for (int ks = 0; ks < 4; ++ks) {
      bf16x8 af[4], bfr[2];
#pragma unroll
      for (int mb = 0; mb < 4; ++mb) af[mb] = *reinterpret_cast<const bf16x8*>(la + g_lds_off(wm * 128 + mb * 32 + r32, ks * 2 + hi));
#pragma unroll
      for (int nb2 = 0; nb2 < 2; ++nb2) bfr[nb2] = *reinterpret_cast<const bf16x8*>(lb + g_lds_off(wn * 64 + nb2 * 32 + r32, ks * 2 + hi));
#pragma unroll
      for (int mb = 0; mb < 4; ++mb)
#pragma unroll
        for (int nb2 = 0; nb2 < 2; ++nb2) acc[mb][nb2] = __builtin_amdgcn_mfma_f32_32x32x16_bf16(af[mb], bfr[nb2], acc[mb][nb2], 0, 0, 0);
    }
    if (kt + 1 < KT1) G_WRITE((kt + 1) & 1);
    __syncthreads();
  }
  if (nm0 >= 0) G_LOAD_AT(0, nm0, nn0);
  const int rbase = m0 + wm * 128, cbase = n0 + wn * 64;
  if (MODE == 1) {
    const float* xin = (layer == 0) ? P.x : P.out;
#pragma unroll
    for (int mb = 0; mb < 4; ++mb)
#pragma unroll
      for (int r = 0; r < 16; ++r) {
        const size_t row = rbase + mb * 32 + crow(r, hi);
#pragma unroll
        for (int nb2 = 0; nb2 < 2; ++nb2) { const size_t idx = row * DM + cbase + nb2 * 32 + r32; P.out[idx] = xin[idx] + acc[mb][nb2][r]; }
      }
  } else if (MODE == 2) {
    u16* o = P.MemKVp() + (size_t)layer * NB * MEML * DM;
#pragma unroll
    for (int mb = 0; mb < 4; ++mb)
#pragma unroll
      for (int r = 0; r < 16; ++r) {
        const size_t row = rbase + mb * 32 + crow(r, hi);
#pragma unroll
        for (int nb2 = 0; nb2 < 2; ++nb2) o[row * DM + cbase + nb2 * 32 + r32] = f2bf(acc[mb][nb2][r]);
      }
  } else {
    const int region = n0 >> 9;
    const int cl = (cbase & 511);
    if (region <= 1) {
      u16* o = (region == 0) ? P.Qp() : P.Kp();
#pragma unroll
      for (int mb = 0; mb < 4; ++mb)
#pragma unroll
        for (int r = 0; r < 16; ++r) {
          const int row = rbase + mb * 32 + crow(r, hi);
          const int pos = row & (SEQ - 1);
          const float c = P.ropeCp()[pos * 32 + r32], s = P.ropeSp()[pos * 32 + r32];
          const float x1 = acc[mb][0][r], x2 = acc[mb][1][r];
          const float qs = (region == 0) ? 0.125f * 1.4426950408889634f : 1.f;
          o[(size_t)row * GW + cl + r32] = f2bf((x1 * c - x2 * s) * qs);
          o[(size_t)row * GW + cl + 32 + r32] = f2bf((x2 * c + x1 * s) * qs);
        }
    } else if (region >= 4 && region <= 7) {
      const int hc0 = cbase - 2048;
#pragma unroll
      for (int mb = 0; mb < 4; ++mb)
#pragma unroll
        for (int nb2 = 0; nb2 < 2; ++nb2)
#pragma unroll
          for (int g = 0; g < 4; ++g) {
            const int row = rbase + mb * 32 + 8 * g + 4 * hi;
            const int b = row >> 13, s = row & (SEQ - 1);
            u32x2 w = {cvtpk(acc[mb][nb2][4 * g], acc[mb][nb2][4 * g + 1]), cvtpk(acc[mb][nb2][4 * g + 2], acc[mb][nb2][4 * g + 3])};
            *reinterpret_cast<u32x2*>(P.HYTp() + ((size_t)(b * 2048 + hc0 + nb2 * 32 + r32)) * SEQ + s) = w;
          }
    } else {
      u16* o = P.Qp() + (size_t)((region >= 8) ? region - 4 : region) * ((size_t)NTOK * GW);
#pragma unroll
      for (int mb = 0; mb < 4; ++mb)
#pragma unroll
        for (int r = 0; r < 16; ++r) {
          const size_t row = rbase + mb * 32 + crow(r, hi);
#pragma unroll
          for (int nb2 = 0; nb2 < 2; ++nb2) o[row * GW + cl + nb2 * 32 + r32] = f2bf(acc[mb][nb2][r] * ((region == 8) ? 0.088388347648318440f * 1.4426950408889634f : 1.f));
        }
    }
  }
  if (nm0 >= 0) G_WRITE(0);
#undef G_LOAD
#undef G_LOAD_AT
#undef G_WRITE
}

constexpr int KVBLK = 64;
constexpr size_t SHM_V = KVBLK * 128 * 2, SHM_K = KVBLK * 128 * 2;
constexpr float THR = 8.f;
#define KSWZ(row, colB) ((row) * 256 + ((colB) ^ (((row) & 7) << 4)))

template <int SCALE_I>
struct ScaleC {};

constexpr float THRL = 8.f * 1.4426950408889634f;
__device__ __forceinline__ void partialSM_first(f32x16& p0, f32x16& p1, float& m_reg, float& alpha) {
  float pmax = p0[0];
#pragma unroll
  for (int r = 1; r < 16; ++r) pmax = fmaxf(pmax, p0[r]);
#pragma unroll
  for (int r = 0; r < 16; ++r) pmax = fmaxf(pmax, p1[r]);
  { auto rr = __builtin_amdgcn_permlane32_swap(__float_as_uint(pmax), __float_as_uint(pmax), false, false);
    pmax = fmaxf(__uint_as_float(rr[0]), __uint_as_float(rr[1])); }
  m_reg += pmax; alpha = 1.f;
#pragma unroll
  for (int r = 0; r < 16; ++r) p0[r] -= pmax;
#pragma unroll
  for (int r = 0; r < 16; ++r) p1[r] -= pmax;
#pragma unroll
  for (int r = 0; r < 16; ++r) p0[r] = __builtin_amdgcn_exp2f(p0[r]);
}
__device__ __forceinline__ void finishSM(f32x16& p0, f32x16& p1, float alpha, float& l_reg, bf16x8& pa0, bf16x8& pa1, bf16x8& pa2, bf16x8& pa3) {
#pragma unroll
  for (int r = 0; r < 16; ++r) p1[r] = __builtin_amdgcn_exp2f(p1[r]);
  float ps = 0;
#pragma unroll
  for (int r = 0; r < 16; ++r) ps += p0[r];
#pragma unroll
  for (int r = 0; r < 16; ++r) ps += p1[r];
  { auto rr = __builtin_amdgcn_permlane32_swap(__float_as_uint(ps), __float_as_uint(ps), false, false);
    ps = __uint_as_float(rr[0]) + __uint_as_float(rr[1]); }
  l_reg = l_reg * alpha + ps;
#define PK4(P, BASE, OUT) do { unsigned a0 = cvtpk(P[BASE + 0], P[BASE + 1]), a1 = cvtpk(P[BASE + 2], P[BASE + 3]);   \
    unsigned b0 = cvtpk(P[BASE + 4], P[BASE + 5]), b1 = cvtpk(P[BASE + 6], P[BASE + 7]);                              \
    auto r0 = __builtin_amdgcn_permlane32_swap(a0, b0, false, false); auto r1 = __builtin_amdgcn_permlane32_swap(a1, b1, false, false); \
    u32x4 w = {r0[0], r1[0], r0[1], r1[1]}; OUT = *reinterpret_cast<bf16x8*>(&w); } while (0)
  PK4(p0, 0, pa0); PK4(p0, 8, pa1); PK4(p1, 0, pa2); PK4(p1, 8, pa3);
#undef PK4
}
template <int NKS>
__device__ __forceinline__ void qkt(f32x16& p0, f32x16& p1, const char* Ks, const bf16x8* qr, int r32, int hi, int kcolB, float minit) {
#pragma unroll
  for (int r = 0; r < 16; ++r) { p0[r] = minit; p1[r] = minit; }
#pragma unroll
  for (int d0 = 0; d0 < NKS; ++d0) { const int cb = kcolB + (d0 * 16 + hi * 8) * 2;
    bf16x8 b0 = *reinterpret_cast<const bf16x8*>(Ks + KSWZ(r32, cb));
    bf16x8 b1 = *reinterpret_cast<const bf16x8*>(Ks + KSWZ(32 + r32, cb));
    p0 = __builtin_amdgcn_mfma_f32_32x32x16_bf16(b0, qr[d0], p0, 0, 0, 0);
    p1 = __builtin_amdgcn_mfma_f32_32x32x16_bf16(b1, qr[d0], p1, 0, 0, 0); }
}
__device__ __forceinline__ int v_st(int k, int c) { const int kk = (k & ~0xC) | ((k & 4) << 1) | ((k & 8) >> 1); return ((kk >> 3) * 4 + (c >> 5)) * 512 + ((kk & 7) * 32 + (c & 31)) * 2; }
__device__ __forceinline__ int v_rd_base(int lane) { return ((lane & 3) << 3) | (((lane >> 2) & 3) << 6) | (((lane >> 4) & 1) << 5) | (((lane >> 5) & 1) << 8); }
constexpr int v_rd_off(int d0, int ks, int half) { return d0 * 512 + ks * 4096 + half * 2048; }
template <int OFF> __device__ __forceinline__ s16x4 tr_read(int vb) {
  s16x4 r; asm volatile("ds_read_b64_tr_b16 %0, %1 offset:%2" : "=&v"(r) : "v"(vb), "i"(OFF) : "memory"); return r;
}
template <int D0> __device__ __forceinline__ void pv_one(f32x16& od, int vb, bf16x8 pa0, bf16x8 pa1, bf16x8 pa2, bf16x8 pa3) {
  const s16x4 l0 = tr_read<v_rd_off(D0, 0, 0)>(vb), h0 = tr_read<v_rd_off(D0, 0, 1)>(vb), l1 = tr_read<v_rd_off(D0, 1, 0)>(vb), h1 = tr_read<v_rd_off(D0, 1, 1)>(vb);
  const s16x4 l2 = tr_read<v_rd_off(D0, 2, 0)>(vb), h2 = tr_read<v_rd_off(D0, 2, 1)>(vb), l3 = tr_read<v_rd_off(D0, 3, 0)>(vb), h3 = tr_read<v_rd_off(D0, 3, 1)>(vb);
  asm volatile("s_waitcnt lgkmcnt(0)" ::: "memory"); SBAR();
#define PK(L, H) (bf16x8){L[0], L[1], L[2], L[3], H[0], H[1], H[2], H[3]}
  od = __builtin_amdgcn_mfma_f32_32x32x16_bf16(pa0, PK(l0, h0), od, 0, 0, 0);
  od = __builtin_amdgcn_mfma_f32_32x32x16_bf16(pa1, PK(l1, h1), od, 0, 0, 0);
  od = __builtin_amdgcn_mfma_f32_32x32x16_bf16(pa2, PK(l2, h2), od, 0, 0, 0);
  od = __builtin_amdgcn_mfma_f32_32x32x16_bf16(pa3, PK(l3, h3), od, 0, 0, 0);
#undef PK
}
__device__ __forceinline__ void pv_d0(f32x16* o, int vb, bf16x8 pa0, bf16x8 pa1, bf16x8 pa2, bf16x8 pa3) {
  pv_one<0>(o[0], vb, pa0, pa1, pa2, pa3); pv_one<1>(o[1], vb, pa0, pa1, pa2, pa3); pv_one<2>(o[2], vb, pa0, pa1, pa2, pa3); pv_one<3>(o[3], vb, pa0, pa1, pa2, pa3);
}

__device__ __forceinline__ void pv_sm(f32x16* o, int vb, bf16x8 pa0, bf16x8 pa1, bf16x8 pa2, bf16x8 pa3,
                                      f32x16& p0, f32x16& p1, float& m_reg, float& alpha) {
  pv_one<0>(o[0], vb, pa0, pa1, pa2, pa3);
  float pmax = p0[0];
#pragma unroll
  for (int r = 1; r < 16; ++r) pmax = fmaxf(pmax, p0[r]);
  pv_one<1>(o[1], vb, pa0, pa1, pa2, pa3);
#pragma unroll
  for (int r = 0; r < 16; ++r) pmax = fmaxf(pmax, p1[r]);
  { auto rr = __builtin_amdgcn_permlane32_swap(__float_as_uint(pmax), __float_as_uint(pmax), false, false);
    pmax = fmaxf(__uint_as_float(rr[0]), __uint_as_float(rr[1])); }
  pv_one<2>(o[2], vb, pa0, pa1, pa2, pa3);
  if (__builtin_expect(__all(pmax <= THRL), 1)) { alpha = 1.f; }
  else {
    const float dl = fmaxf(pmax, 0.f);
    alpha = __builtin_amdgcn_exp2f(-dl); m_reg += dl;
#pragma unroll
    for (int r = 0; r < 16; ++r) p0[r] -= dl;
#pragma unroll
    for (int r = 0; r < 16; ++r) p1[r] -= dl;
  }
  pv_one<3>(o[3], vb, pa0, pa1, pa2, pa3);
#pragma unroll
  for (int r = 0; r < 16; ++r) p0[r] = __builtin_amdgcn_exp2f(p0[r]);
}

template <bool DIFF>
__device__ __forceinline__ void attn_item(const Params& P, int layer, const u16* __restrict__ Qlane, const u16* __restrict__ Kh, const u16* __restrict__ Vh,
                                          int seq, int tok0, int hcol, float lam, float post, char* lds, int TIDX) {
  constexpr int NKS = DIFF ? 4 : 8;
  constexpr int LDK = DIFF ? GW : DM;
  int tid = TIDX; asm volatile("" : "+v"(tid));
  const int wid = tid >> 6, lane = tid & 63, r32 = lane & 31, hi = lane >> 5;
  const int mp = DIFF ? (wid >> 2) : 0;
  char* V_lds = lds; char* K_lds = lds + 2 * SHM_V;
  float* ws = (float*)(lds + 2 * SHM_V + 2 * SHM_K) + wid * 64; float* li_l = ws; float* al_l = ws + 32;
  float m_reg = 0.f, l_reg = 0; f32x16 o[4];
#pragma unroll
  for (int d = 0; d < 4; ++d) o[d] = f32x16{};
  bf16x8 qr[NKS];
#pragma unroll
  for (int d0 = 0; d0 < NKS; ++d0) qr[d0] = *reinterpret_cast<const bf16x8*>(Qlane + d0 * 16);
  const int kcolB = mp * 128;
  const int sr = tid >> 4, sc = (tid & 15) * 8, vst0 = v_st(sr, sc), vst1 = v_st(32 + sr, sc);
  const int vb0 = (int)(uintptr_t)V_lds + v_rd_base(lane);
  constexpr int SD = DIFF ? 2 : 1;
  struct { bf16x8 vs0, vs1, ks0, ks1; } sr_[SD];
#define SLOAD(i, k0) do { sr_[i].vs0 = *reinterpret_cast<const bf16x8*>(&Vh[(long)((k0) + sr) * LDK + sc]); sr_[i].vs1 = *reinterpret_cast<const bf16x8*>(&Vh[(long)((k0) + 32 + sr) * LDK + sc]); \
    sr_[i].ks0 = *reinterpret_cast<const bf16x8*>(&Kh[(long)((k0) + sr) * LDK + sc]); sr_[i].ks1 = *reinterpret_cast<const bf16x8*>(&Kh[(long)((k0) + 32 + sr) * LDK + sc]); } while (0)
#define SWRITE(b, i) do { *(bf16x8*)(V_lds + (b) * SHM_V + vst0) = sr_[i].vs0;          \
    *(bf16x8*)(V_lds + (b) * SHM_V + vst1) = sr_[i].vs1; int kc = sc * 2;               \
    *(bf16x8*)(K_lds + (b) * SHM_K + KSWZ(sr, kc)) = sr_[i].ks0;                       \
    *(bf16x8*)(K_lds + (b) * SHM_K + KSWZ(32 + sr, kc)) = sr_[i].ks1; } while (0)
#define SWAIT() do { if constexpr (SD == 2) asm volatile("s_waitcnt vmcnt(4)" ::: "memory"); else asm volatile("s_waitcnt vmcnt(0)" ::: "memory"); } while (0)
#define RESC(a) do { if (__any((a) < 1.f)) { if (hi == 0) al_l[r32] = (a); asm volatile("s_waitcnt lgkmcnt(0)" ::: "memory"); \
    _Pragma("unroll") for (int d = 0; d < 4; ++d) _Pragma("unroll") for (int r = 0; r < 16; ++r) o[d][r] *= al_l[crow(r, hi)]; } } while (0)
  f32x16 pA0, pA1, pB0, pB1; float alA, alB; bf16x8 pa0, pa1, pa2, pa3; const int NT = seq / KVBLK;
  constexpr int SE = 0, SO = SD - 1;
  __syncthreads();
  SLOAD(SE, 0); asm volatile("s_waitcnt vmcnt(0)" ::: "memory"); SWRITE(0, SE); __syncthreads();
  qkt<NKS>(pA0, pA1, K_lds, qr, r32, hi, kcolB, 0.f); partialSM_first(pA0, pA1, m_reg, alA);
  SLOAD(SO, KVBLK); if constexpr (SD == 2) { if (2 < NT) SLOAD(SE, 2 * KVBLK); }
  SWAIT(); SWRITE(1, SO); __syncthreads();
  for (int j = 1; j + 1 < NT; j += 2) {
    SBAR(); qkt<NKS>(pB0, pB1, K_lds + SHM_K, qr, r32, hi, kcolB, -m_reg);
    finishSM(pA0, pA1, alA, l_reg, pa0, pa1, pa2, pa3); SBAR();
    SLOAD(SO, (j + SD) * KVBLK); SBAR();
    pv_sm(o, vb0, pa0, pa1, pa2, pa3, pB0, pB1, m_reg, alB);
    __syncthreads(); SWAIT(); SWRITE(0, SE);
    RESC(alB); __syncthreads();
    SBAR(); qkt<NKS>(pA0, pA1, K_lds, qr, r32, hi, kcolB, -m_reg);
    finishSM(pB0, pB1, alB, l_reg, pa0, pa1, pa2, pa3); SBAR();
    if (SD == 1 || j + 3 < NT) SLOAD(SE, (j + 1 + SD) * KVBLK); SBAR();
    pv_sm(o, vb0 + (int)SHM_V, pa0, pa1, pa2, pa3, pA0, pA1, m_reg, alA);
    __syncthreads(); SWAIT(); SWRITE(1, SO);
    RESC(alA); __syncthreads();
  }
  SBAR(); qkt<NKS>(pB0, pB1, K_lds + SHM_K, qr, r32, hi, kcolB, -m_reg);
  finishSM(pA0, pA1, alA, l_reg, pa0, pa1, pa2, pa3); SBAR();
  pv_sm(o, vb0, pa0, pa1, pa2, pa3, pB0, pB1, m_reg, alB);
  __syncthreads(); RESC(alB);
  finishSM(pB0, pB1, alB, l_reg, pa0, pa1, pa2, pa3); SBAR();
  pv_d0(o, vb0 + (int)SHM_V, pa0, pa1, pa2, pa3);
  if (hi == 0) li_l[r32] = l_reg; asm volatile("s_waitcnt lgkmcnt(0)" ::: "memory");
  float rli[16];
#pragma unroll
  for (int r = 0; r < 16; ++r) rli[r] = __builtin_amdgcn_rcpf(li_l[crow(r, hi)]);
  if (DIFF) {
    const int qw = wid & 3;
    float* X = (float*)lds;
    __syncthreads();
    if (mp == 1) {
#pragma unroll
      for (int r = 0; r < 16; ++r)
#pragma unroll
        for (int d0 = 0; d0 < 4; ++d0) X[(qw * 32 + crow(r, hi)) * 128 + d0 * 32 + r32] = o[d0][r] * rli[r];
    }
    __syncthreads();
    if (mp == 0) {
      float ss[16];
#pragma unroll
      for (int r = 0; r < 16; ++r) {
        float s2 = 0;
#pragma unroll
        for (int d0 = 0; d0 < 4; ++d0) { const float v = o[d0][r] * rli[r] - lam * X[(qw * 32 + crow(r, hi)) * 128 + d0 * 32 + r32]; o[d0][r] = v; s2 += v * v; }
        ss[r] = s2;
      }
#pragma unroll
      for (int r = 0; r < 16; ++r) {
#pragma unroll
        for (int m = 16; m >= 1; m >>= 1) ss[r] += __shfl_xor(ss[r], m);
      }
      float gs[4];
#pragma unroll
      for (int d0 = 0; d0 < 4; ++d0) gs[d0] = P.g_sub[layer * 128 + d0 * 32 + r32] * post;
#pragma unroll
      for (int r = 0; r < 16; ++r) {
        const float rs = rsqrtf(ss[r] * (1.f / 128.f) + EPS);
        const size_t tok = tok0 + crow(r, hi);
#pragma unroll
        for (int d0 = 0; d0 < 4; ++d0) {
          const size_t idx = tok * GW + hcol + d0 * 32 + r32;
          const float g = bf2f(P.GAp()[idx]);
          P.YAp()[idx] = f2bf(o[d0][r] * rs * gs[d0] * silu(g));
        }
      }
    }
    __syncthreads();
  } else {
#pragma unroll
    for (int r = 0; r < 16; ++r) {
      const size_t tok = tok0 + crow(r, hi);
#pragma unroll
      for (int d0 = 0; d0 < 4; ++d0) {
        const size_t idx = tok * GW + hcol + d0 * 32 + r32;
        const float g = bf2f(P.MGp()[idx]);
        P.GAp()[idx] = f2bf(o[d0][r] * rli[r] * silu(g));
      }
    }
    __syncthreads();
  }
#undef SLOAD
#undef SWRITE
#undef SWAIT
#undef RESC
}

__device__ __forceinline__ void phase_attn(const Params& P, int layer, char* lds, int TIDX, int BIDX) {
  const int wid = TIDX >> 6, lane = TIDX & 63, r32 = lane & 31, hi = lane >> 5;
  float d1 = P.lq1[layer * 64 + lane] * P.lk1[layer * 64 + lane], d2 = P.lq2[layer * 64 + lane] * P.lk2[layer * 64 + lane];
  d1 = wave_sum(d1); d2 = wave_sum(d2);
  const float lam_init = 0.8f - 0.6f * expf(-0.3f * (float)layer);
  const float lam = expf(d1) - expf(d2) + lam_init;
  const float post = 1.f - lam_init;
  const int nb = gridDim.x;
#pragma unroll 1
  for (int rep = 0; rep < REP_ATT; ++rep)
  for (int it = BIDX; it < 512; it += nb) {
    const int bh = it & 7, qb = it >> 3, b = bh >> 2, h = bh & 3;
    const int mp = wid >> 2, qw = wid & 3;
    const int tok0 = b * SEQ + qb * 128 + qw * 32;
    const u16* Qlane = P.Qp() + (size_t)(tok0 + r32) * GW + h * 128 + mp * 64 + hi * 8;
    const u16* Kh = P.Kp() + (size_t)(b * SEQ) * GW + h * 128;
    const u16* Vh = P.Vp() + (size_t)(b * SEQ) * GW + h * 128;
    attn_item<true>(P, layer, Qlane, Kh, Vh, SEQ, tok0, h * 128, lam, post, lds, TIDX);
  }
  if (layer == 0) {
    for (int it = BIDX; it < 16; it += nb) { const int r = it & 7; if (it < 8) gemm_tile<2>(P, 0, (r >> 2) * 256, (r & 3) * 256, lds, TIDX); else gemm_tile<2>(P, 1, (r >> 2) * 256, (r & 3) * 256, lds, TIDX); }
  }
}

__device__ __forceinline__ constexpr float CW(int k) {
  switch (k & 31) {
    case 0: return 1.f; case 1: return 0.98078528040323043f; case 2: return 0.92387953251128674f; case 3: return 0.83146961230254524f;
    case 4: return 0.70710678118654752f; case 5: return 0.55557023301960218f; case 6: return 0.38268343236508978f; case 7: return 0.19509032201612825f;
    case 8: return 0.f; case 9: return -0.19509032201612825f; case 10: return -0.38268343236508978f; case 11: return -0.55557023301960218f;
    case 12: return -0.70710678118654752f; case 13: return -0.83146961230254524f; case 14: return -0.92387953251128674f; case 15: return -0.98078528040323043f;
    default: return -1.f; }
}
__device__ __forceinline__ constexpr float SWc(int k) {
  switch (k & 31) {
    case 0: return 0.f; case 1: return 0.19509032201612825f; case 2: return 0.38268343236508978f; case 3: return 0.55557023301960218f;
    case 4: return 0.70710678118654752f; case 5: return 0.83146961230254524f; case 6: return 0.92387953251128674f; case 7: return 0.98078528040323043f;
    case 8: return 1.f; case 9: return 0.98078528040323043f; case 10: return 0.92387953251128674f; case 11: return 0.83146961230254524f;
    case 12: return 0.70710678118654752f; case 13: return 0.55557023301960218f; case 14: return 0.38268343236508978f; case 15: return 0.19509032201612825f;
    default: return 0.f; }
}
__device__ __forceinline__ constexpr int brev5(int p) { return ((p & 1) << 4) | ((p & 2) << 2) | (p & 4) | ((p & 8) >> 2) | ((p & 16) >> 4); }
__device__ __forceinline__ int fsw(int a) { return a ^ (((a >> 5) & 15) | (((a >> 9) & 1) << 4)); }

using f2 = __attribute__((ext_vector_type(2))) float;
__device__ __forceinline__ f2 cmul_neg(f2 d, float c, float s) { return d * c + f2{d[1], -d[0]} * s; }
__device__ __forceinline__ f2 cmul_pos(f2 d, float c, float s) { return d * c + f2{-d[1], d[0]} * s; }
template <int R, bool INV, int OFF>
__device__ __forceinline__ void fft_net(f2 (&x)[32]) {
  constexpr int LOGR = (R == 32) ? 5 : 4;
  if (!INV) {
#pragma unroll
    for (int lg = LOGR - 1; lg >= 0; --lg) {
      const int h = 1 << lg;
#pragma unroll
      for (int i = 0; i < R; ++i) {
        if (i & h) continue;
        const int k = (i & (h - 1)) * (16 / h);
        const f2 a = x[OFF + i], b = x[OFF + i + h];
        x[OFF + i] = a + b;
        const f2 d = a - b;
        if (k == 0) x[OFF + i + h] = d;
        else if (k == 8) x[OFF + i + h] = f2{d[1], -d[0]};
        else x[OFF + i + h] = cmul_neg(d, CW(k), SWc(k));
      }
    }
  } else {
#pragma unroll
    for (int lg = 0; lg < LOGR; ++lg) {
      const int h = 1 << lg;
#pragma unroll
      for (int i = 0; i < R; ++i) {
        if (i & h) continue;
        const int k = (i & (h - 1)) * (16 / h);
        const f2 a = x[OFF + i], B = x[OFF + i + h];
        f2 b;
        if (k == 0) b = B;
        else if (k == 8) b = f2{-B[1], B[0]};
        else b = cmul_pos(B, CW(k), SWc(k));
        x[OFF + i] = a + b; x[OFF + i + h] = a - b;
      }
    }
  }
}
template <bool INV, int LOGN>
__device__ __forceinline__ void twiddle32(f2 (&x)[32], int j) {
  asm volatile("" : "+v"(j));
  const float turns = (float)j * (1.f / (float)(1 << LOGN));
  const float c1 = __builtin_amdgcn_cosf(turns), s1 = __builtin_amdgcn_sinf(turns);
  const f2 w2 = {c1 * c1 - s1 * s1, 2.f * c1 * s1};
  f2 we = {1.f, 0.f}, wo = {c1, s1};
#pragma unroll
  for (int r = 1; r < 32; ++r) {
    f2 w;
    if (r & 1) { w = wo; wo = cmul_pos(wo, w2[0], w2[1]); }
    else { we = cmul_pos(we, w2[0], w2[1]); w = we; }
    const int p = brev5(r);
    x[p] = INV ? cmul_pos(x[p], w[0], w[1]) : cmul_neg(x[p], w[0], w[1]);
  }
}
__device__ __forceinline__ void fft_fwd_p0(f2 (&x)[32], f2* D, int t) {
  asm volatile("" : "+v"(t));
  fft_net<32, false, 0>(x);
  twiddle32<false, 14>(x, t);
  const int e0 = t ^ ((t >> 5) & 15), e1 = e0 ^ 16;
#pragma unroll
  for (int p = 0; p < 32; ++p) D[p * 512 + ((p & 1) ? e1 : e0)] = x[p];
}
__device__ __forceinline__ void fft_fwd_p1(f2 (&x)[32], f2* D, int t) {
  asm volatile("" : "+v"(t));
  const int j = t & 15, blk = t >> 4, b0 = blk * 512 + ((blk & 1) << 4), b1 = b0 ^ 16;
#pragma unroll
  for (int q = 0; q < 32; ++q) x[q] = D[((q & 1) ? b1 : b0) + (q >> 1) * 32 + (j ^ (q >> 1))];
  fft_net<32, false, 0>(x);
  twiddle32<false, 9>(x, j);
#pragma unroll
  for (int p = 0; p < 32; ++p) D[((p & 1) ? b1 : b0) + (p >> 1) * 32 + (j ^ (p >> 1))] = x[p];
}
__device__ __forceinline__ void fft_p2_load(f2 (&x)[32], f2* D, int t) {
  asm volatile("" : "+v"(t));
#pragma unroll
  for (int u = 0; u < 2; ++u) {
    const int B = u * 512 + t, hb = (B * 16) ^ (((B >> 5) & 1) << 4), m4 = (B >> 1) & 15;
#pragma unroll
    for (int q = 0; q < 16; ++q) x[u * 16 + q] = D[hb + (q ^ m4)];
  }
  fft_net<16, false, 0>(x); fft_net<16, false, 16>(x);
}
__device__ __forceinline__ void fft_p2_inv_store(f2 (&x)[32], f2* D, int t) {
  asm volatile("" : "+v"(t));
  fft_net<16, true, 0>(x); fft_net<16, true, 16>(x);
#pragma unroll
  for (int u = 0; u < 2; ++u) {
    const int B = u * 512 + t, hb = (B * 16) ^ (((B >> 5) & 1) << 4), m4 = (B >> 1) & 15;
#pragma unroll
    for (int q = 0; q < 16; ++q) D[hb + (q ^ m4)] = x[u * 16 + q];
  }
}
__device__ __forceinline__ void fft_inv_p1(f2 (&x)[32], f2* D, int t) {
  asm volatile("" : "+v"(t));
  const int j = t & 15, blk = t >> 4, b0 = blk * 512 + ((blk & 1) << 4), b1 = b0 ^ 16;
#pragma unroll
  for (int q = 0; q < 32; ++q) x[q] = D[((q & 1) ? b1 : b0) + (q >> 1) * 32 + (j ^ (q >> 1))];
  twiddle32<true, 9>(x, j);
  fft_net<32, true, 0>(x);
#pragma unroll
  for (int p = 0; p < 32; ++p) D[((p & 1) ? b1 : b0) + (p >> 1) * 32 + (j ^ (p >> 1))] = x[p];
}
__device__ __forceinline__ void fft_inv_p0(f2 (&x)[32], f2* D, int t) {
  asm volatile("" : "+v"(t));
  const int e0 = t ^ ((t >> 5) & 15), e1 = e0 ^ 16;
#pragma unroll
  for (int q = 0; q < 32; ++q) x[q] = D[q * 512 + ((q & 1) ? e1 : e0)];
  twiddle32<true, 14>(x, t);
  fft_net<32, true, 0>(x);
}

__device__ __forceinline__ float sc_val(const u16* __restrict__ hy, int s, float w0, float w1, float w2, float bias) {
  const int sl = s > 0 ? s - 1 : 0, sr2 = s < SEQ - 1 ? s + 1 : SEQ - 1;
  const float c = bf2f(hy[s]);
  const float l = bf2f(hy[sl]) * (s > 0 ? 1.f : 0.f);
  const float r = bf2f(hy[sr2]) * (s < SEQ - 1 ? 1.f : 0.f);
  return w0 * l + w1 * c + w2 * r + bias;
}

constexpr int STG_B = 16416, STG_COL = 2 * STG_B;
__device__ __forceinline__ void stage_col(const u16* __restrict__ hy0, const u16* __restrict__ hy1, int col, char* lds, int off, int t) {
  const u32x4* g0 = reinterpret_cast<const u32x4*>(hy0 + (size_t)col * SEQ);
  const u32x4* g1 = reinterpret_cast<const u32x4*>(hy1 + (size_t)col * SEQ);
  const u32x4 a0 = g0[t], a1 = g0[t + 512], b0 = g1[t], b1 = g1[t + 512];
  char* s0 = lds + off + 16; char* s1 = s0 + STG_B;
  *reinterpret_cast<u32x4*>(s0 + t * 16) = a0; *reinterpret_cast<u32x4*>(s0 + (t + 512) * 16) = a1;
  *reinterpret_cast<u32x4*>(s1 + t * 16) = b0; *reinterpret_cast<u32x4*>(s1 + (t + 512) * 16) = b1;
  if (t < 2) { char* sb = t ? s1 : s0; *reinterpret_cast<u16*>(sb - 2) = 0; *reinterpret_cast<u16*>(sb + 16384) = 0; }
}
__device__ __forceinline__ float sc_lds(const char* base, int s, float w0, float w1, float w2, float bias) {
  const u16* p = reinterpret_cast<const u16*>(base);
  return w0 * bf2f(p[s - 1]) + w1 * bf2f(p[s]) + w2 * bf2f(p[s + 1]) + bias;
}

__device__ __forceinline__ void hyena_channel(const Params& P, int layer, int c, char* lds, int TIDX, int BIDX) {
  f2* D = (f2*)lds; float* kcl = (float*)lds; float* wl = (float*)(lds + 131072);
  int t = TIDX; asm volatile("" : "+v"(t));
  const float* cw = P.conv_w + (size_t)layer * 3 * 1536; const float* cb = P.conv_b + (size_t)layer * 1536;
  const u16* hy0 = P.HYTp(); const u16* hy1 = P.HYTp() + (size_t)2048 * SEQ;
  const float min_decay = -3.0701134573253944f, max_decay = -15.350567286626972f;
  const float dF = fabsf(min_decay + (max_decay - min_decay) * ((float)c / 511.f));
  const float dB = fabsf(min_decay + (max_decay - min_decay) * ((float)(511 - c) / 511.f));
  typedef _Float16 h2_t __attribute__((ext_vector_type(2)));
  h2_t* KFH = reinterpret_cast<h2_t*>(P.Kp()) + (size_t)BIDX * 32768 + t * 32;
  {
    float* kcl1 = (float*)(lds + 65536);
    __syncthreads();
    {
      int tf = t; asm volatile("" : "+v"(tf));
      const int lane = tf & 63, r32 = lane & 31, hi = lane >> 5, wv = tf >> 6;
      bf16x8 af[4];
#pragma unroll
      for (int ks = 0; ks < 4; ++ks) {
        float wv8[8];
#pragma unroll
        for (int i = 0; i < 8; ++i) {
          const int rr = r32 & 3;
          const float x = P.hf_w4[((size_t)layer * 64 + ks * 16 + hi * 8 + i) * 2048 + (rr >> 1) * 1024 + (rr & 1) * 512 + c];
          wv8[i] = (r32 < 4) ? x : 0.f;
        }
        u32x4 w = {cvtpk(wv8[0], wv8[1]), cvtpk(wv8[2], wv8[3]), cvtpk(wv8[4], wv8[5]), cvtpk(wv8[6], wv8[7])};
        af[ks] = *reinterpret_cast<bf16x8*>(&w);
      }
      const u16* hb = reinterpret_cast<const u16*>(P.hdnp()) + ((size_t)layer * SEQ + wv * 1024 + r32) * 64 + hi * 8;
#pragma unroll 1
      for (int g = 0; g < 4; ++g) {
        bf16x8 bfr[8][4];
#pragma unroll
        for (int pb = 0; pb < 8; ++pb)
#pragma unroll
          for (int ks = 0; ks < 4; ++ks) bfr[pb][ks] = *reinterpret_cast<const bf16x8*>(hb + (size_t)((g * 8 + pb) * 32) * 64 + ks * 16);
#pragma unroll
        for (int pb = 0; pb < 8; ++pb) {
          f32x16 acc = f32x16{};
#pragma unroll
          for (int ks = 0; ks < 4; ++ks) acc = __builtin_amdgcn_mfma_f32_32x32x16_bf16(af[ks], bfr[pb][ks], acc, 0, 0, 0);
          if (hi == 0) {
            const int tt = wv * 1024 + (g * 8 + pb) * 32 + r32; const float tl = (float)tt * (1.f / 8191.f);
            const float ef = __expf(-tl * dF), eb = (tt == SEQ - 1) ? 0.f : __expf(-tl * dB);
            kcl[tt] = acc[0] * ef; kcl[16383 - tt] = acc[1] * eb;
            kcl1[tt] = acc[2] * ef; kcl1[16383 - tt] = acc[3] * eb;
          }
        }
      }
    }
    __syncthreads();
    f2 x[32];
#pragma unroll
    for (int q = 0; q < 32; ++q) x[q] = f2{kcl[q * 512 + t], kcl1[q * 512 + t]};
    __syncthreads();
    fft_fwd_p0(x, D, t); __syncthreads();
    fft_fwd_p1(x, D, t); __syncthreads();
    fft_p2_load(x, D, t);
    {
      int tx = t; asm volatile("" : "+v"(tx));
#pragma unroll
      for (int u = 0; u < 2; ++u) {
        const int B = u * 512 + tx, hb = (B * 16) ^ (((B >> 5) & 1) << 4), m4 = (B >> 1) & 15;
#pragma unroll
        for (int q = 0; q < 16; ++q) D[hb + (q ^ m4)] = x[u * 16 + q];
      }
      __syncthreads();
#pragma unroll
      for (int u = 0; u < 2; ++u)
#pragma unroll
        for (int q = 0; q < 16; ++q) {
          const unsigned a = (unsigned)((u * 512 + tx) * 16 + q);
          const unsigned kfreq = __builtin_bitreverse32(a) >> 18;
          const unsigned ap = __builtin_bitreverse32((16384u - kfreq) & 16383u) >> 18;
          const f2 v = D[fsw((int)ap)];
          const float wr = x[u * 16 + q][0], wi = x[u * 16 + q][1];
          h2_t k0 = {(_Float16)(0.5f * (wr + v[0])), (_Float16)(0.5f * (wi - v[1]))};
          h2_t k1 = {(_Float16)(0.5f * (wi + v[1])), (_Float16)(0.5f * (v[0] - wr))};
          KFH[u * 16 + q] = k0; KFH[16384 + u * 16 + q] = k1;
        }
    }
  }
  float zr[16], zi[16];
  {
    const float w0 = cw[c], w1 = cw[1536 + c], w2 = cw[3072 + c], bb = cb[c];
    __syncthreads();
    stage_col(hy0, hy1, c, lds, 0, t);
    __syncthreads();
#pragma unroll
    for (int q = 0; q < 16; ++q) { const int s = q * 512 + t; zr[q] = sc_lds(lds + 16, s, w0, w1, w2, bb); zi[q] = sc_lds(lds + 16 + STG_B, s, w0, w1, w2, bb); }
  }
#pragma unroll 1
  for (int order = 0; order < 2; ++order) {
    const h2_t* KF = KFH + order * 16384;
    f2 x[32];
#pragma unroll
    for (int q = 0; q < 16; ++q) { x[q] = f2{zr[q], zi[q]}; x[q + 16] = f2{0.f, 0.f}; }
    __syncthreads();
    fft_fwd_p0(x, D, t); __syncthreads();
    fft_fwd_p1(x, D, t); __syncthreads();
    fft_p2_load(x, D, t);
#pragma unroll
    for (int q = 0; q < 32; ++q) { const h2_t kh = KF[q]; const float k0 = (float)kh[0] * (1.f / 16384.f), k1 = (float)kh[1] * (1.f / 16384.f); x[q] = cmul_pos(x[q], k0, k1); }
    fft_p2_inv_store(x, D, t); __syncthreads();
    fft_inv_p1(x, D, t); __syncthreads();
    fft_inv_p0(x, D, t);
    int te = t; asm volatile("" : "+v"(te));
    const float skip = P.hy_skip[((size_t)layer * 2 + order) * 512 + c];
    const int xc = (order == 0 ? 512 : 1024) + c;
    const float w0 = cw[xc], w1 = cw[1536 + xc], w2 = cw[3072 + xc], bb = cb[xc];
    __syncthreads();
    stage_col(hy0, hy1, xc, lds, 0, te);
    if (order == 1) stage_col(hy0, hy1, 1536 + c, lds, STG_COL, te);
    __syncthreads();
    if (order == 0) {
#pragma unroll
      for (int q = 0; q < 16; ++q) {
        const int s = q * 512 + te;
        const float x0 = sc_lds(lds + 16, s, w0, w1, w2, bb), x1 = sc_lds(lds + 16 + STG_B, s, w0, w1, w2, bb);
        zr[q] = x0 * (x[q][0] + skip * zr[q]); zi[q] = x1 * (x[q][1] + skip * zi[q]);
      }
    } else {
#pragma unroll
      for (int q = 0; q < 16; ++q) {
        const int s = q * 512 + te;
        const float x0 = sc_lds(lds + 16, s, w0, w1, w2, bb), x1 = sc_lds(lds + 16 + STG_B, s, w0, w1, w2, bb);
        const float g0 = bf2f(reinterpret_cast<const u16*>(lds + STG_COL + 16)[s]), g1 = bf2f(reinterpret_cast<const u16*>(lds + STG_COL + 16 + STG_B)[s]);
        P.YBp()[(size_t)s * GW + c] = f2bf(x0 * (x[q][0] + skip * zr[q]) * silu(g0));
        P.YBp()[(size_t)(SEQ + s) * GW + c] = f2bf(x1 * (x[q][1] + skip * zi[q]) * silu(g1));
      }
    }
  }
}

__device__ __forceinline__ void phase_hyena_cross(const Params& P, int layer, char* lds, int TIDX, int BIDX) {
  const int nb = gridDim.x;
#pragma unroll 1
  for (int rep = 0; rep < REP_HY; ++rep)
  for (int ci = BIDX; ci < GW; ci += nb) {
    const int c = (nb == 256) ? 64 * (BIDX & 7) + 2 * (BIDX >> 3) + (ci >> 8) : ci;
    hyena_channel(P, layer, c, lds, TIDX, BIDX);
  }
  __syncthreads();
  const int wid = TIDX >> 6, lane = TIDX & 63, r32 = lane & 31, hi = lane >> 5;
#pragma unroll 1
  for (int rep = 0; rep < REP_CROSS; ++rep)
  for (int it = BIDX; it < 256; it += nb) {
    const int h = it & 3, blk = it >> 2;
    const int tok0 = blk * 256 + wid * 32, b = tok0 >> 13;
    const u16* Qlane = P.MQp() + (size_t)(tok0 + r32) * GW + h * 128 + hi * 8;
    const u16* Kh = P.MemKVp() + ((size_t)layer * NB * MEML + b * MEML) * DM + h * 128;
    attn_item<false>(P, layer, Qlane, Kh, Kh + GW, MEML, tok0, h * 128, 0.f, 1.f, lds, TIDX);
  }
}

template <int PH>
__device__ __forceinline__ void run_phase(const Params& P, char* lds, int wave_s) {
  int TIDX = (wave_s << 6) | (int)__builtin_amdgcn_mbcnt_hi(~0u, __builtin_amdgcn_mbcnt_lo(~0u, 0u)); asm volatile("" : "+v"(TIDX));
  int BIDX = blockIdx.x; asm volatile("" : "+s"(BIDX));
  const int nb = gridDim.x, bid = BIDX;
  if constexpr (PH == 0) {
#pragma unroll 1
    for (int rep = 0; rep < REP_PREP; ++rep) phase_prep(P, lds, TIDX, BIDX); }
  else {
    constexpr int layer = (PH - 1) / 5, sub = (PH - 1) % 5;
    if constexpr (sub == 0) {
#pragma unroll 1
      for (int rep = 0; rep < REP_PROJ; ++rep)
      { bool pre = false;
        for (int it = bid; it < 64 * 20; it += nb) { const int tn = it >> 6, tm = it & 63; const int nx = it + nb; const bool hn = nx < 64 * 20;
          gemm_tile<0>(P, layer, tm * 256, tn * 256, lds, TIDX, pre, hn ? (nx & 63) * 256 : -1, hn ? (nx >> 6) * 256 : 0); pre = hn; } }
    } else if constexpr (sub == 1) {
      phase_attn(P, layer, lds, TIDX, BIDX);
    } else if constexpr (sub == 2) {
      phase_hyena_cross(P, layer, lds, TIDX, BIDX);
    } else if constexpr (sub == 3) {
#pragma unroll 1
      for (int rep = 0; rep < (layer == 0 ? REP_OUT0 : 1); ++rep)
      for (int it = bid; it < 64 * 4; it += nb) { const int tn = it >> 6, tm = it & 63; gemm_tile<1>(P, layer, tm * 256, tn * 256, lds, TIDX); }
    } else {
      const int wid = TIDX >> 6, lane = TIDX & 63;
      if constexpr (layer == 0) {
#pragma unroll 1
        for (int rep = 0; rep < REP_NORM0; ++rep)
        for (int it = bid; it < NTOK / 8; it += nb) { const int row = it * 8 + wid; norm_row_bf16(P.out + (size_t)row * DM, P.g_norm + DM, P.Hp() + (size_t)row * DM, lane); }
      } else {
        for (int it = bid; it < NTOK / 8; it += nb) { const int row = it * 8 + wid; norm_row_f32(P.out + (size_t)row * DM, P.g_final, lane); }
      }
    }
  }
}

#define XB_TMO      128
#define XB_XCNT(j)  (256  + 64 * (j))
#define XB_XSUB(j)  (1280 + 64 * (j))
#define XB_XGEN(j)  (2304 + 64 * (j))
#define XB_TOP      3328
#define XB_TOPGEN   3392
#define XCD_BAR_WORDS 3456
#define XB_SPIN_CAP (1u << 18)
#define LAS __attribute__((address_space(3)))

__device__ __forceinline__ unsigned xb_ld(unsigned* p)              { return __hip_atomic_load(p, __ATOMIC_RELAXED, __HIP_MEMORY_SCOPE_AGENT); }
__device__ __forceinline__ unsigned xb_add(unsigned* p, unsigned v) { return __hip_atomic_fetch_add(p, v, __ATOMIC_RELAXED, __HIP_MEMORY_SCOPE_AGENT); }
__device__ __forceinline__ unsigned xb_xcc_id() { return (unsigned)__builtin_amdgcn_s_getreg((3 << 11) | 20) & 0xFu; }
#define XB_SPIN(cond, bar) do { unsigned _sp = 0; while (cond) { __builtin_amdgcn_s_sleep(1); \
    if ((++_sp & 255u) == 0u) { if (xb_ld(&(bar)[XB_TMO])) break; if (_sp > XB_SPIN_CAP) { atomicAdd(&(bar)[XB_TMO], 1u); break; } } } } while (0)

struct XcdBarrier {
    unsigned* bar; unsigned x;
    volatile LAS unsigned* st;
};

__device__ __forceinline__ XcdBarrier xcd_barrier_post(unsigned* bar, volatile LAS unsigned* st) {
    XcdBarrier b; b.bar = bar; b.x = xb_xcc_id(); b.st = st;
    if (threadIdx.x == 0) (void)xb_add(&bar[XB_XCNT(b.x)], 1u);
    return b;
}
__device__ __forceinline__ void xcd_barrier_complete(unsigned* bar, unsigned x, unsigned& nloc, unsigned& nx) {
    const unsigned G = gridDim.x * gridDim.y * gridDim.z;
    unsigned sum, cnt, mine, sp = 0u;
    for (;;) {
        sum = 0u; cnt = 0u; mine = 0u;
#pragma unroll
        for (unsigned j = 0; j < 16; ++j) { const unsigned c = xb_ld(&bar[XB_XCNT(j)]); sum += c; cnt += (c > 0u) ? 1u : 0u; mine = (j == x) ? c : mine; }
        if (sum == G) break;
        __builtin_amdgcn_s_sleep(1);
        if ((++sp & 255u) == 0u) { if (xb_ld(&bar[XB_TMO])) break; if (sp > XB_SPIN_CAP) { atomicAdd(&bar[XB_TMO], 1u); break; } }
    }
    nloc = mine > 0u ? mine : 1u; nx = cnt > 0u ? cnt : 1u;
}

__device__ __forceinline__ void xcd_barrier(const XcdBarrier& b) {
    asm volatile("s_waitcnt vmcnt(0)" ::: "memory");
    __syncthreads();
    if (threadIdx.x == 0) {
        unsigned* bar = b.bar;
        __builtin_amdgcn_s_waitcnt(0);
        unsigned nloc = b.st[0], nx = b.st[1];
        if (nloc == 0u) { xcd_barrier_complete(bar, b.x, nloc, nx); b.st[0] = nloc; b.st[1] = nx; }
        const unsigned old = xb_add(&bar[XB_XSUB(b.x)], 1u);
        const unsigned gen = old / nloc;
        if (old + 1u == (gen + 1u) * nloc) {
            __builtin_amdgcn_fence(__ATOMIC_RELEASE, "agent");
            asm volatile("s_waitcnt vmcnt(0)" ::: "memory");
            const unsigned og = xb_add(&bar[XB_TOP], 1u);
            const unsigned tg = og / nx;
            if (og + 1u == (tg + 1u) * nx) xb_add(&bar[XB_TOPGEN], 1u);
            else XB_SPIN(xb_ld(&bar[XB_TOPGEN]) == tg, bar);
            __builtin_amdgcn_fence(__ATOMIC_ACQUIRE, "agent");
            xb_add(&bar[XB_XGEN(b.x)], 1u);
            asm volatile("s_waitcnt vmcnt(0)" ::: "memory");
        } else {
            XB_SPIN(xb_ld(&bar[XB_XGEN(b.x)]) == gen, bar);
            __builtin_amdgcn_fence(__ATOMIC_ACQUIRE, "agent");
            asm volatile("s_waitcnt vmcnt(0)" ::: "memory");
        }
    }
    __syncthreads();
}

template <bool SINGLE>
__global__ __launch_bounds__(512) void mega(Params P) {
  extern __shared__ __attribute__((aligned(16))) char lds[];
  const int wave_s = __builtin_amdgcn_readfirstlane((int)threadIdx.x >> 6);
  if constexpr (SINGLE) {
    cg::grid_group grid = cg::this_grid();
    __shared__ unsigned xb_st[4];
    if (threadIdx.x < 4) xb_st[threadIdx.x] = 0u;
    __syncthreads();
    const XcdBarrier xb = xcd_barrier_post((unsigned*)(P.ws + (size_t)232 * 1048576), (volatile LAS unsigned*)xb_st);
    if (P.phase_hi < 0) grid.sync();
    run_phase<0>(P, lds, wave_s); xcd_barrier(xb);
    run_phase<1>(P, lds, wave_s); xcd_barrier(xb);
    run_phase<2>(P, lds, wave_s); xcd_barrier(xb);
    run_phase<3>(P, lds, wave_s); xcd_barrier(xb);
    run_phase<4>(P, lds, wave_s); xcd_barrier(xb);
    run_phase<5>(P, lds, wave_s); xcd_barrier(xb);
    run_phase<6>(P, lds, wave_s); xcd_barrier(xb);
    run_phase<7>(P, lds, wave_s); xcd_barrier(xb);
    run_phase<8>(P, lds, wave_s); xcd_barrier(xb);
    run_phase<9>(P, lds, wave_s); xcd_barrier(xb);
    run_phase<10>(P, lds, wave_s);
  } else {
    switch (P.phase_lo) {
      case 0: run_phase<0>(P, lds, wave_s); break;
      case 1: run_phase<1>(P, lds, wave_s); break;
      case 2: run_phase<2>(P, lds, wave_s); break;
      case 3: run_phase<3>(P, lds, wave_s); break;
      case 4: run_phase<4>(P, lds, wave_s); break;
      case 5: run_phase<5>(P, lds, wave_s); break;
      case 6: run_phase<6>(P, lds, wave_s); break;
      case 7: run_phase<7>(P, lds, wave_s); break;
      case 8: run_phase<8>(P, lds, wave_s); break;
      case 9: run_phase<9>(P, lds, wave_s); break;
      default: run_phase<10>(P, lds, wave_s); break;
    }
  }
}

extern "C" void kernel_launch(void* const* d_in, const int* in_sizes, int n_in, void* d_out, int out_size, void* d_ws, size_t ws_size, hipStream_t stream) {
  static int grid = 0;
  if (grid == 0) {
    int dev = 0, cus = 0, per_cu = 0;
    hipGetDevice(&dev);
    hipDeviceGetAttribute(&cus, hipDeviceAttributeMultiprocessorCount, dev);
    if (hipFuncSetAttribute((const void*)MEGA, hipFuncAttributeMaxDynamicSharedMemorySize, LDS_BYTES) != hipSuccess) { fprintf(stderr, "hipFuncSetAttribute failed\n"); grid = -1; return; }
    hipOccupancyMaxActiveBlocksPerMultiprocessor(&per_cu, (const void*)MEGA, 512, LDS_BYTES);
    (void)hipGetLastError();
    (void)per_cu;
    grid = cus < 256 ? cus : 256;
  }
  if (grid < 0) return;
  Params p{};
  const float** f = (const float**)&p.x;
  for (int i = 0; i < 24; ++i) f[i] = (const float*)d_in[i];
  p.out = (float*)d_out;
  p.ws = (char*)d_ws;
#if ONE_LAUNCH
  p.phase_lo = 0; p.phase_hi = NPHASE;
  hipMemsetAsync((char*)d_ws + (size_t)232 * 1048576, 0, 16384, stream);
  void* args[] = {&p};
  hipError_t e = hipLaunchCooperativeKernel((const void*)MEGA, dim3(grid), dim3(512), args, LDS_BYTES, stream);
  if (e != hipSuccess) fprintf(stderr, "cooperative launch failed: %s (grid %d)\n", hipGetErrorString(e), grid);
#else
  for (int ph = 0; ph < NPHASE; ++ph) {
    p.phase_lo = ph; p.phase_hi = ph + 1;
    hipLaunchKernelGGL(MEGA, dim3(grid), dim3(512), LDS_BYTES, stream, p);
  }
#endif
}
```

```cpp
#include <hip/hip_runtime.h>
#include <hip/hip_bf16.h>
#include <hip/hip_cooperative_groups.h>
#include <cstdio>
#include <cstdint>
namespace cg = cooperative_groups;

typedef unsigned short u16;
using bf16x8 = __attribute__((ext_vector_type(8))) short;
using s16x4  = __attribute__((ext_vector_type(4))) short;
using f32x16 = __attribute__((ext_vector_type(16))) float;
using f32x4  = __attribute__((ext_vector_type(4))) float;
using u32x4  = __attribute__((ext_vector_type(4))) unsigned;
using u32x2  = __attribute__((ext_vector_type(2))) unsigned;

constexpr int DM = 1024, NB = 2, SEQ = 8192, NTOK = NB * SEQ, DEPTH = 2;
constexpr int GW = 512, DIN = 5120, DMIX = 1536, MEML = 256;
constexpr float EPS = 1e-6f;
constexpr int NPHASE = 11;
#define REP_HY 1
#define REP_OUT0 1
#define REP_CROSS 1
#define REP_NORM0 1
#define REP_ATT 1
#define REP_PROJ 1
#define REP_PREP 1
#ifndef ONE_LAUNCH
#define ONE_LAUNCH 1
#endif
#define MEGA mega<(ONE_LAUNCH != 0)>
#define MEGA mega<(ONE_LAUNCH != 0)>
#ifndef DBG_SKIP_MIX
#define DBG_SKIP_MIX 0
#endif
#ifndef DBG_NPH
#define DBG_NPH 11
#endif
#ifndef DBG_KT_LO
#define DBG_KT_LO 0
#endif
#ifndef DBG_KT_HI
#define DBG_KT_HI 24
#endif
constexpr int LDS_BYTES = 131072 + 1024;

struct Params {
  const float *x, *mem, *g_norm, *w_in, *lq1, *lk1, *lq2, *lk2, *g_sub, *conv_w, *conv_b;
  const float *hf_w1, *hf_b1, *hf_w2, *hf_b2, *hf_w3, *hf_b3, *hf_w4, *hf_freq, *hy_skip, *g_mem, *w_mem_kv, *w_out, *g_final;
  float* out;
  char* ws;
  int phase_lo, phase_hi;
#define WSF(name, type, mib) __device__ __forceinline__ type* name() const { return (type*)(ws + (size_t)(mib) * 1048576); }
  WSF(Qp, u16, 0) WSF(Kp, u16, 16) WSF(Vp, u16, 32) WSF(GAp, u16, 48) WSF(MQp, u16, 64) WSF(MGp, u16, 80) WSF(HYTp, u16, 96)
  WSF(Hp, u16, 160) WSF(YBp, u16, 160) WSF(YAp, u16, 176) WSF(WinTp, u16, 192) WSF(WoutTp, u16, 212) WSF(WmTp, u16, 218) WSF(Mnp, u16, 222) WSF(MemKVp, u16, 224)
  WSF(hdnp, float, 226) WSF(ropeCp, float, 230) WSF(ropeSp, float, 231)
#undef WSF
};

#define SBAR() __builtin_amdgcn_sched_barrier(0)
__device__ __forceinline__ int crow(int r, int hi) { return (r & 3) + 8 * (r >> 2) + 4 * hi; }
typedef __bf16 bf2_t __attribute__((ext_vector_type(2)));
typedef float fl2_t __attribute__((ext_vector_type(2)));
__device__ __forceinline__ unsigned cvtpk(float lo, float hi) {
  fl2_t f = {lo, hi};
  bf2_t b = __builtin_convertvector(f, bf2_t);
  return __builtin_bit_cast(unsigned, b);
}
__device__ __forceinline__ u16 f2bf(float x) { return __builtin_bit_cast(u16, (__bf16)x); }
__device__ __forceinline__ float bf2f(u16 v) { return __uint_as_float(((unsigned)v) << 16); }
__device__ __forceinline__ float silu(float x) { return x / (1.f + __expf(-x)); }
__device__ __forceinline__ float wave_sum(float v) {
  for (int m = 32; m >= 1; m >>= 1) v += __shfl_xor(v, m);
  return v;
}

__device__ __forceinline__ void transpose_tile(const float* __restrict__ W, u16* __restrict__ WT, int Kd, int Nd, int tk, int tn, char* lds, int TIDX) {
  u16* tile = (u16*)lds;
  const int tid = TIDX;
  const int kr = tid >> 4, nc = (tid & 15) * 4;
  __syncthreads();
#pragma unroll
  for (int i = 0; i < 2; ++i) {
    const int k = kr + 32 * i;
    const f32x4 v = *reinterpret_cast<const f32x4*>(W + (size_t)(tk * 64 + k) * Nd + tn * 64 + nc);
#pragma unroll
    for (int j = 0; j < 4; ++j) tile[(nc + j) * 72 + k] = f2bf(v[j]);
  }
  __syncthreads();
  const int n = tid >> 3, kc = (tid & 7) * 8;
  const u32x4 o = *reinterpret_cast<const u32x4*>(tile + n * 72 + kc);
  *reinterpret_cast<u32x4*>(WT + (size_t)(tn * 64 + n) * Kd + tk * 64 + kc) = o;
}

__device__ __forceinline__ void norm_row_bf16(const float* __restrict__ xr, const float* __restrict__ g, u16* __restrict__ o, int lane) {
  f32x4 v[4]; float ss = 0;
#pragma unroll
  for (int i = 0; i < 4; ++i) { v[i] = *reinterpret_cast<const f32x4*>(xr + i * 256 + lane * 4); ss += v[i][0] * v[i][0] + v[i][1] * v[i][1] + v[i][2] * v[i][2] + v[i][3] * v[i][3]; }
  ss = wave_sum(ss);
  const float rs = rsqrtf(ss * (1.f / 1024.f) + EPS);
#pragma unroll
  for (int i = 0; i < 4; ++i) {
    const f32x4 gg = *reinterpret_cast<const f32x4*>(g + i * 256 + lane * 4);
    u32x2 w = {cvtpk(v[i][0] * rs * gg[0], v[i][1] * rs * gg[1]), cvtpk(v[i][2] * rs * gg[2], v[i][3] * rs * gg[3])};
    *reinterpret_cast<u32x2*>(o + i * 256 + lane * 4) = w;
  }
}
__device__ __forceinline__ void norm_row_f32(float* __restrict__ xr, const float* __restrict__ g, int lane) {
  f32x4 v[4]; float ss = 0;
#pragma unroll
  for (int i = 0; i < 4; ++i) { v[i] = *reinterpret_cast<const f32x4*>(xr + i * 256 + lane * 4); ss += v[i][0] * v[i][0] + v[i][1] * v[i][1] + v[i][2] * v[i][2] + v[i][3] * v[i][3]; }
  ss = wave_sum(ss);
  const float rs = rsqrtf(ss * (1.f / 1024.f) + EPS);
#pragma unroll
  for (int i = 0; i < 4; ++i) {
    const f32x4 gg = *reinterpret_cast<const f32x4*>(g + i * 256 + lane * 4);
    f32x4 w = {v[i][0] * rs * gg[0], v[i][1] * rs * gg[1], v[i][2] * rs * gg[2], v[i][3] * rs * gg[3]};
    *reinterpret_cast<f32x4*>(xr + i * 256 + lane * 4) = w;
  }
}

__device__ __forceinline__ void phase_prep(const Params& P, char* lds, int TIDX, int BIDX) {
  const int tid = TIDX, wid = tid >> 6, lane = tid & 63;
  const int nb = gridDim.x, bid = BIDX;
  {
    constexpr int U_IN = (DIN / 512) * (DM / 32), U_OUT = (DM / 512) * (DMIX / 32), U_M = (DM / 512) * (DM / 32);
    constexpr int U_L = U_IN + U_OUT + U_M;
    for (int it = bid; it < DEPTH * U_L; it += nb) {
      const int l = it / U_L; int r = it % U_L;
      const float* W; u16* WT; int Kd, Nd;
      if (r < U_IN) { W = P.w_in + (size_t)l * DM * DIN; WT = P.WinTp() + (size_t)l * DIN * DM; Kd = DM; Nd = DIN; }
      else if (r < U_IN + U_OUT) { r -= U_IN; W = P.w_out + (size_t)l * DMIX * DM; WT = P.WoutTp() + (size_t)l * DM * DMIX; Kd = DMIX; Nd = DM; }
      else { r -= U_IN + U_OUT; W = P.w_mem_kv + (size_t)l * DM * DM; WT = P.WmTp() + (size_t)l * DM * DM; Kd = DM; Nd = DM; }
      const int nkb = Kd / 32, nblk = r / nkb, kb = r % nkb;
      const int n = nblk * 512 + tid, k0 = kb * 32;
      const float* src = W + (size_t)k0 * Nd + n;
      float v[32];
#pragma unroll
      for (int k = 0; k < 32; ++k) v[k] = src[(size_t)k * Nd];
      u16* dst = WT + (size_t)n * Kd + k0;
#pragma unroll
      for (int c = 0; c < 4; ++c) {
        u32x4 o = {cvtpk(v[c * 8 + 0], v[c * 8 + 1]), cvtpk(v[c * 8 + 2], v[c * 8 + 3]), cvtpk(v[c * 8 + 4], v[c * 8 + 5]), cvtpk(v[c * 8 + 6], v[c * 8 + 7])};
        *reinterpret_cast<u32x4*>(dst + c * 8) = o;
      }
    }
  }
  for (int it = bid; it < NTOK / 8; it += nb) { const int row = it * 8 + wid; norm_row_bf16(P.x + (size_t)row * DM, P.g_norm, P.Hp() + (size_t)row * DM, lane); }
  for (int it = bid; it < DEPTH * NB * MEML / 8; it += nb) {
    const int r = it * 8 + wid, l = r / (NB * MEML), row = r % (NB * MEML);
    norm_row_bf16(P.mem + (size_t)row * DM, P.g_mem + l * DM, P.Mnp() + (size_t)r * DM, lane);
  }
  for (int gg = bid * 8 + wid; gg < DEPTH * SEQ / 8; gg += nb * 8) {
    const int r0 = gg * 8, l = r0 / SEQ, t0 = r0 % SEQ;
    float zf[8];
#pragma unroll
    for (int r = 0; r < 8; ++r) {
      const int tt = t0 + r; float z = 0.f;
      if (lane == 0) z = (float)tt * (1.f / 8191.f);
      else if (lane < 33) {
        const int i = (lane - 1) & 15;
        const float f = 1e-4f + (float)i * ((15.f - 1e-4f) / 15.f);
        const float w = (6.283185307179586f * (float)tt) / 8192.f;
        z = (lane <= 16) ? cosf(f * w) : -sinf(f * w);
      }
      zf[r] = z;
    }
    const float fr = P.hf_freq[l * 64 + lane];
    float a[8], h[8];
    { const float b = P.hf_b1[l * 64 + lane];
#pragma unroll
      for (int r = 0; r < 8; ++r) a[r] = b; }
#pragma unroll 3
    for (int i = 0; i < 33; ++i) { const float w = P.hf_w1[(l * 33 + i) * 64 + lane];
#pragma unroll
      for (int r = 0; r < 8; ++r) a[r] += __int_as_float(__builtin_amdgcn_readlane(__float_as_int(zf[r]), i)) * w; }
#pragma unroll
    for (int r = 0; r < 8; ++r) h[r] = sinf(fr * a[r]);
    { const float b = P.hf_b2[l * 64 + lane];
#pragma unroll
      for (int r = 0; r < 8; ++r) a[r] = b; }
#pragma unroll 4
    for (int i = 0; i < 64; ++i) { const float w = P.hf_w2[(l * 64 + i) * 64 + lane];
#pragma unroll
      for (int r = 0; r < 8; ++r) a[r] += __int_as_float(__builtin_amdgcn_readlane(__float_as_int(h[r]), i)) * w; }
#pragma unroll
    for (int r = 0; r < 8; ++r) h[r] = sinf(fr * a[r]);
    { const float b = P.hf_b3[l * 64 + lane];
#pragma unroll
      for (int r = 0; r < 8; ++r) a[r] = b; }
#pragma unroll 4
    for (int i = 0; i < 64; ++i) { const float w = P.hf_w3[(l * 64 + i) * 64 + lane];
#pragma unroll
      for (int r = 0; r < 8; ++r) a[r] += __int_as_float(__builtin_amdgcn_readlane(__float_as_int(h[r]), i)) * w; }
    u16* o = reinterpret_cast<u16*>(P.hdnp()) + ((size_t)l * SEQ + t0) * 64 + lane;
#pragma unroll
    for (int r = 0; r < 8; ++r) o[r * 64] = f2bf(sinf(fr * a[r]));
  }
  for (int idx = bid * 512 + tid; idx < SEQ * 32; idx += nb * 512) {
    const int pos = idx >> 5, j = idx & 31;
    const float inv = powf(10000.f, -((float)(2 * j) / 64.f));
    const float ang = (float)pos * inv;
    P.ropeCp()[idx] = cosf(ang); P.ropeSp()[idx] = sinf(ang);
  }
}

__device__ __forceinline__ int g_lds_off(int row, int ch) { return row * 128 + ((ch ^ ((row >> 1) & 7)) << 4); }

template <int MODE>
__device__ __forceinline__ void gemm_tile(const Params& P, int layer, int m0, int n0, char* lds, int TIDX, bool preloaded = false, int nm0 = -1, int nn0 = 0) {
  int tid = TIDX; asm volatile("" : "+v"(tid));
  const int wid = tid >> 6, lane = tid & 63, r32 = lane & 31, hi = lane >> 5;
  const int wm = wid >> 2, wn = wid & 3;
  constexpr int K = (MODE == 1) ? DMIX : DM;
  constexpr int NK = K / 64;
  const u16* Bt = (MODE == 0) ? P.WinTp() + (size_t)layer * DIN * DM : (MODE == 1) ? P.WoutTp() + (size_t)layer * DM * DMIX : P.WmTp() + (size_t)layer * DM * DM;
  const int srow = tid >> 3, sch = tid & 7;
  f32x16 acc[4][2];
#pragma unroll
  for (int a = 0; a < 4; ++a)
#pragma unroll
    for (int b = 0; b < 2; ++b) acc[a][b] = f32x16{};
  u32x4 ra[4], rb[4];
  auto a_ptr = [&](int kt, int mm) -> const u16* {
    if (MODE == 0) return P.Hp() + (size_t)mm * DM + kt * 64;
    if (MODE == 2) return P.Mnp() + ((size_t)layer * NB * MEML + mm) * DM + kt * 64;
    const int src = kt >> 3, ko = (kt & 7) * 64;
    const u16* b = (src == 0) ? P.YAp() : (src == 1) ? P.YBp() : P.GAp();
    return b + (size_t)mm * GW + ko;
  };
  constexpr int LDA = (MODE == 1) ? GW : DM;
#define G_LOAD_AT(kt, mm, nn) do { const u16* ap = a_ptr(kt, mm); const u16* bp = Bt + (size_t)(nn) * K + (kt) * 64;                       \
    _Pragma("unroll") for (int i = 0; i < 4; ++i) {                                                                      \
      ra[i] = *reinterpret_cast<const u32x4*>(ap + (size_t)(srow + i * 64) * LDA + sch * 8);                            \
      rb[i] = *reinterpret_cast<const u32x4*>(bp + (size_t)(srow + i * 64) * K + sch * 8); } } while (0)
#define G_WRITE(buf) do { char* la = lds + (buf) * 65536; char* lb = la + 32768;                                          \
    _Pragma("unroll") for (int i = 0; i < 4; ++i) {                                                                      \
      *reinterpret_cast<u32x4*>(la + g_lds_off(srow + i * 64, sch)) = ra[i];                                             \
      *reinterpret_cast<u32x4*>(lb + g_lds_off(srow + i * 64, sch)) = rb[i]; } } while (0)
#define G_LOAD(kt) G_LOAD_AT(kt, m0, n0)
  constexpr int KT0 = 0, KT1 = NK;
  if (!preloaded) { __syncthreads(); G_LOAD(KT0); G_WRITE(KT0 & 1); }
  __syncthreads();
  for (int kt = KT0; kt < KT1; ++kt) {
    if (kt + 1 < KT1) G_LOAD(kt + 1);
    const char* la = lds + (kt & 1) * 65536; const char* lb = la + 32768;
#pragma unroll
    for (int ks = 0; ks < 4; ++ks) {
      bf16x8 af[4], bfr[2];
#pragma unroll
      for (int mb = 0; mb < 4; ++mb) af[mb] = *reinterpret_cast<const bf16x8*>(la + g_lds_off(wm * 128 + mb * 32 + r32, ks * 2 + hi));
#pragma unroll
      for (int nb2 = 0; nb2 < 2; ++nb2) bfr[nb2] = *reinterpret_cast<const bf16x8*>(lb + g_lds_off(wn * 64 + nb2 * 32 + r32, ks * 2 + hi));
#pragma unroll
      for (int mb = 0; mb < 4; ++mb)
#pragma unroll
        for (int nb2 = 0; nb2 < 2; ++nb2) acc[mb][nb2] = __builtin_amdgcn_mfma_f32_32x32x16_bf16(af[mb], bfr[nb2], acc[mb][nb2], 0, 0, 0);
    }
    if (kt + 1 < KT1) G_WRITE((kt + 1) & 1);
    __syncthreads();
  }
  if (nm0 >= 0) G_LOAD_AT(0, nm0, nn0);
  const int rbase = m0 + wm * 128, cbase = n0 + wn * 64;
  if (MODE == 1) {
    const float* xin = (layer == 0) ? P.x : P.out;
#pragma unroll
    for (int mb = 0; mb < 4; ++mb)
#pragma unroll
      for (int r = 0; r < 16; ++r) {
        const size_t row = rbase + mb * 32 + crow(r, hi);
#pragma unroll
        for (int nb2 = 0; nb2 < 2; ++nb2) { const size_t idx = row * DM + cbase + nb2 * 32 + r32; P.out[idx] = xin[idx] + acc[mb][nb2][r]; }
      }
  } else if (MODE == 2) {
    u16* o = P.MemKVp() + (size_t)layer * NB * MEML * DM;
#pragma unroll
    for (int mb = 0; mb < 4; ++mb)
#pragma unroll
      for (int r = 0; r < 16; ++r) {
        const size_t row = rbase + mb * 32 + crow(r, hi);
#pragma unroll
        for (int nb2 = 0; nb2 < 2; ++nb2) o[row * DM + cbase + nb2 * 32 + r32] = f2bf(acc[mb][nb2][r]);
      }
  } else {
    const int region = n0 >> 9;
    const int cl = (cbase & 511);
    if (region <= 1) {
      u16* o = (region == 0) ? P.Qp() : P.Kp();
#pragma unroll
      for (int mb = 0; mb < 4; ++mb)
#pragma unroll
        for (int r = 0; r < 16; ++r) {
          const int row = rbase + mb * 32 + crow(r, hi);
          const int pos = row & (SEQ - 1);
          const float c = P.ropeCp()[pos * 32 + r32], s = P.ropeSp()[pos * 32 + r32];
          const float x1 = acc[mb][0][r], x2 = acc[mb][1][r];
          const float qs = (region == 0) ? 0.125f * 1.4426950408889634f : 1.f;
          o[(size_t)row * GW + cl + r32] = f2bf((x1 * c - x2 * s) * qs);
          o[(size_t)row * GW + cl + 32 + r32] = f2bf((x2 * c + x1 * s) * qs);
        }
    } else if (region >= 4 && region <= 7) {
      const int hc0 = cbase - 2048;
#pragma unroll
      for (int mb = 0; mb < 4; ++mb)
#pragma unroll
        for (int nb2 = 0; nb2 < 2; ++nb2)
#pragma unroll
          for (int g = 0; g < 4; ++g) {
            const int row = rbase + mb * 32 + 8 * g + 4 * hi;
            const int b = row >> 13, s = row & (SEQ - 1);
            u32x2 w = {cvtpk(acc[mb][nb2][4 * g], acc[mb][nb2][4 * g + 1]), cvtpk(acc[mb][nb2][4 * g + 2], acc[mb][nb2][4 * g + 3])};
            *reinterpret_cast<u32x2*>(P.HYTp() + ((size_t)(b * 2048 + hc0 + nb2 * 32 + r32)) * SEQ + s) = w;
          }
    } else {
      u16* o = P.Qp() + (size_t)((region >= 8) ? region - 4 : region) * ((size_t)NTOK * GW);
#pragma unroll
      for (int mb = 0; mb < 4; ++mb)
#pragma unroll
        for (int r = 0; r < 16; ++r) {
          const size_t row = rbase + mb * 32 + crow(r, hi);
#pragma unroll
          for (int nb2 = 0; nb2 < 2; ++nb2) o[row * GW + cl + nb2 * 32 + r32] = f2bf(acc[mb][nb2][r] * ((region == 8) ? 0.088388347648318440f * 1.4426950408889634f : 1.f));
        }
    }
  }
  if (nm0 >= 0) G_WRITE(0);
#undef G_LOAD
#undef G_LOAD_AT
#undef G_WRITE
}

constexpr int KVBLK = 64;
constexpr size_t SHM_V = KVBLK * 128 * 2, SHM_K = KVBLK * 128 * 2;
constexpr float THR = 8.f;
#define KSWZ(row, colB) ((row) * 256 + ((colB) ^ (((row) & 7) << 4)))

template <int SCALE_I>
struct ScaleC {};

constexpr float THRL = 8.f * 1.4426950408889634f;
__device__ __forceinline__ void partialSM_first(f32x16& p0, f32x16& p1, float& m_reg, float& alpha) {
  float pmax = p0[0];
#pragma unroll
  for (int r = 1; r < 16; ++r) pmax = fmaxf(pmax, p0[r]);
#pragma unroll
  for (int r = 0; r < 16; ++r) pmax = fmaxf(pmax, p1[r]);
  { auto rr = __builtin_amdgcn_permlane32_swap(__float_as_uint(pmax), __float_as_uint(pmax), false, false);
    pmax = fmaxf(__uint_as_float(rr[0]), __uint_as_float(rr[1])); }
  m_reg += pmax; alpha = 1.f;
#pragma unroll
  for (int r = 0; r < 16; ++r) p0[r] -= pmax;
#pragma unroll
  for (int r = 0; r < 16; ++r) p1[r] -= pmax;
#pragma unroll
  for (int r = 0; r < 16; ++r) p0[r] = __builtin_amdgcn_exp2f(p0[r]);
}
__device__ __forceinline__ void finishSM(f32x16& p0, f32x16& p1, float alpha, float& l_reg, bf16x8& pa0, bf16x8& pa1, bf16x8& pa2, bf16x8& pa3) {
#pragma unroll
  for (int r = 0; r < 16; ++r) p1[r] = __builtin_amdgcn_exp2f(p1[r]);
  float ps = 0;
#pragma unroll
  for (int r = 0; r < 16; ++r) ps += p0[r];
#pragma unroll
  for (int r = 0; r < 16; ++r) ps += p1[r];
  { auto rr = __builtin_amdgcn_permlane32_swap(__float_as_uint(ps), __float_as_uint(ps), false, false);
    ps = __uint_as_float(rr[0]) + __uint_as_float(rr[1]); }
  l_reg = l_reg * alpha + ps;
#define PK4(P, BASE, OUT) do { unsigned a0 = cvtpk(P[BASE + 0], P[BASE + 1]), a1 = cvtpk(P[BASE + 2], P[BASE + 3]);   \
    unsigned b0 = cvtpk(P[BASE + 4], P[BASE + 5]), b1 = cvtpk(P[BASE + 6], P[BASE + 7]);                              \
    auto r0 = __builtin_amdgcn_permlane32_swap(a0, b0, false, false); auto r1 = __builtin_amdgcn_permlane32_swap(a1, b1, false, false); \
    u32x4 w = {r0[0], r1[0], r0[1], r1[1]}; OUT = *reinterpret_cast<bf16x8*>(&w); } while (0)
  PK4(p0, 0, pa0); PK4(p0, 8, pa1); PK4(p1, 0, pa2); PK4(p1, 8, pa3);
#undef PK4
}
template <int NKS>
__device__ __forceinline__ void qkt(f32x16& p0, f32x16& p1, const char* Ks, const bf16x8* qr, int r32, int hi, int kcolB, float minit) {
#pragma unroll
  for (int r = 0; r < 16; ++r) { p0[r] = minit; p1[r] = minit; }
#pragma unroll
  for (int d0 = 0; d0 < NKS; ++d0) { const int cb = kcolB + (d0 * 16 + hi * 8) * 2;
    bf16x8 b0 = *reinterpret_cast<const bf16x8*>(Ks + KSWZ(r32, cb));
    bf16x8 b1 = *reinterpret_cast<const bf16x8*>(Ks + KSWZ(32 + r32, cb));
    p0 = __builtin_amdgcn_mfma_f32_32x32x16_bf16(b0, qr[d0], p0, 0, 0, 0);
    p1 = __builtin_amdgcn_mfma_f32_32x32x16_bf16(b1, qr[d0], p1, 0, 0, 0); }
}
__device__ __forceinline__ int v_st(int k, int c) { const int kk = (k & ~0xC) | ((k & 4) << 1) | ((k & 8) >> 1); return ((kk >> 3) * 4 + (c >> 5)) * 512 + ((kk & 7) * 32 + (c & 31)) * 2; }
__device__ __forceinline__ int v_rd_base(int lane) { return ((lane & 3) << 3) | (((lane >> 2) & 3) << 6) | (((lane >> 4) & 1) << 5) | (((lane >> 5) & 1) << 8); }
constexpr int v_rd_off(int d0, int ks, int half) { return d0 * 512 + ks * 4096 + half * 2048; }
template <int OFF> __device__ __forceinline__ s16x4 tr_read(int vb) {
  s16x4 r; asm volatile("ds_read_b64_tr_b16 %0, %1 offset:%2" : "=&v"(r) : "v"(vb), "i"(OFF) : "memory"); return r;
}
template <int D0> __device__ __forceinline__ void pv_one(f32x16& od, int vb, bf16x8 pa0, bf16x8 pa1, bf16x8 pa2, bf16x8 pa3) {
  const s16x4 l0 = tr_read<v_rd_off(D0, 0, 0)>(vb), h0 = tr_read<v_rd_off(D0, 0, 1)>(vb), l1 = tr_read<v_rd_off(D0, 1, 0)>(vb), h1 = tr_read<v_rd_off(D0, 1, 1)>(vb);
  const s16x4 l2 = tr_read<v_rd_off(D0, 2, 0)>(vb), h2 = tr_read<v_rd_off(D0, 2, 1)>(vb), l3 = tr_read<v_rd_off(D0, 3, 0)>(vb), h3 = tr_read<v_rd_off(D0, 3, 1)>(vb);
  asm volatile("s_waitcnt lgkmcnt(0)" ::: "memory"); SBAR();
#define PK(L, H) (bf16x8){L[0], L[1], L[2], L[3], H[0], H[1], H[2], H[3]}
  od = __builtin_amdgcn_mfma_f32_32x32x16_bf16(pa0, PK(l0, h0), od, 0, 0, 0);
  od = __builtin_amdgcn_mfma_f32_32x32x16_bf16(pa1, PK(l1, h1), od, 0, 0, 0);
  od = __builtin_amdgcn_mfma_f32_32x32x16_bf16(pa2, PK(l2, h2), od, 0, 0, 0);
  od = __builtin_amdgcn_mfma_f32_32x32x16_bf16(pa3, PK(l3, h3), od, 0, 0, 0);
#undef PK
}
__device__ __forceinline__ void pv_d0(f32x16* o, int vb, bf16x8 pa0, bf16x8 pa1, bf16x8 pa2, bf16x8 pa3) {
  pv_one<0>(o[0], vb, pa0, pa1, pa2, pa3); pv_one<1>(o[1], vb, pa0, pa1, pa2, pa3); pv_one<2>(o[2], vb, pa0, pa1, pa2, pa3); pv_one<3>(o[3], vb, pa0, pa1, pa2, pa3);
}

__device__ __forceinline__ void pv_sm(f32x16* o, int vb, bf16x8 pa0, bf16x8 pa1, bf16x8 pa2, bf16x8 pa3,
                                      f32x16& p0, f32x16& p1, float& m_reg, float& alpha) {
  pv_one<0>(o[0], vb, pa0, pa1, pa2, pa3);
  float pmax = p0[0];
#pragma unroll
  for (int r = 1; r < 16; ++r) pmax = fmaxf(pmax, p0[r]);
  pv_one<1>(o[1], vb, pa0, pa1, pa2, pa3);
#pragma unroll
  for (int r = 0; r < 16; ++r) pmax = fmaxf(pmax, p1[r]);
  { auto rr = __builtin_amdgcn_permlane32_swap(__float_as_uint(pmax), __float_as_uint(pmax), false, false);
    pmax = fmaxf(__uint_as_float(rr[0]), __uint_as_float(rr[1])); }
  pv_one<2>(o[2], vb, pa0, pa1, pa2, pa3);
  if (__builtin_expect(__all(pmax <= THRL), 1)) { alpha = 1.f; }
  else {
    const float dl = fmaxf(pmax, 0.f);
    alpha = __builtin_amdgcn_exp2f(-dl); m_reg += dl;
#pragma unroll
    for (int r = 0; r < 16; ++r) p0[r] -= dl;
#pragma unroll
    for (int r = 0; r < 16; ++r) p1[r] -= dl;
  }
  pv_one<3>(o[3], vb, pa0, pa1, pa2, pa3);
#pragma unroll
  for (int r = 0; r < 16; ++r) p0[r] = __builtin_amdgcn_exp2f(p0[r]);
}

template <bool DIFF>
__device__ __forceinline__ void attn_item(const Params& P, int layer, const u16* __restrict__ Qlane, const u16* __restrict__ Kh, const u16* __restrict__ Vh,
                                          int seq, int tok0, int hcol, float lam, float post, char* lds, int TIDX) {
  constexpr int NKS = DIFF ? 4 : 8;
  constexpr int LDK = DIFF ? GW : DM;
  int tid = TIDX; asm volatile("" : "+v"(tid));
  const int wid = tid >> 6, lane = tid & 63, r32 = lane & 31, hi = lane >> 5;
  const int mp = DIFF ? (wid >> 2) : 0;
  char* V_lds = lds; char* K_lds = lds + 3 * SHM_V;
  float* ws = (float*)(lds + 3 * SHM_V + 3 * SHM_K) + wid * 64; float* li_l = ws; float* al_l = ws + 32;
  float m_reg = 0.f, l_reg = 0; f32x16 o[4];
#pragma unroll
  for (int d = 0; d < 4; ++d) o[d] = f32x16{};
  bf16x8 qr[NKS];
#pragma unroll
  for (int d0 = 0; d0 < NKS; ++d0) qr[d0] = *reinterpret_cast<const bf16x8*>(Qlane + d0 * 16);
  const int kcolB = mp * 128;
  const int sr = tid >> 4, sc = (tid & 15) * 8, vst0 = v_st(sr, sc), vst1 = v_st(32 + sr, sc);
  const int vb0 = (int)(uintptr_t)V_lds + v_rd_base(lane);
  constexpr int SD = DIFF ? 2 : 1;
  struct { bf16x8 vs0, vs1, ks0, ks1; } sr_[SD];
#define SLOAD(i, k0) do { sr_[i].vs0 = *reinterpret_cast<const bf16x8*>(&Vh[(long)((k0) + sr) * LDK + sc]); sr_[i].vs1 = *reinterpret_cast<const bf16x8*>(&Vh[(long)((k0) + 32 + sr) * LDK + sc]); \
    sr_[i].ks0 = *reinterpret_cast<const bf16x8*>(&Kh[(long)((k0) + sr) * LDK + sc]); sr_[i].ks1 = *reinterpret_cast<const bf16x8*>(&Kh[(long)((k0) + 32 + sr) * LDK + sc]); } while (0)
#define SWRITE(b, i) do { *(bf16x8*)(V_lds + (b) * SHM_V + vst0) = sr_[i].vs0;          \
    *(bf16x8*)(V_lds + (b) * SHM_V + vst1) = sr_[i].vs1; int kc = sc * 2;               \
    *(bf16x8*)(K_lds + (b) * SHM_K + KSWZ(sr, kc)) = sr_[i].ks0;                       \
    *(bf16x8*)(K_lds + (b) * SHM_K + KSWZ(32 + sr, kc)) = sr_[i].ks1; } while (0)
#define SWAIT() do { if constexpr (SD == 2) asm volatile("s_waitcnt vmcnt(4)" ::: "memory"); else asm volatile("s_waitcnt vmcnt(0)" ::: "memory"); } while (0)
#define RESC(a) do { if (__any((a) < 1.f)) { if (hi == 0) al_l[r32] = (a); asm volatile("s_waitcnt lgkmcnt(0)" ::: "memory"); \
    _Pragma("unroll") for (int d = 0; d < 4; ++d) _Pragma("unroll") for (int r = 0; r < 16; ++r) o[d][r] *= al_l[crow(r, hi)]; } } while (0)
  f32x16 pA0, pA1, pB0, pB1; float alA, alB; bf16x8 pa0, pa1, pa2, pa3; const int NT = seq / KVBLK;
  constexpr int SE = 0, SO = SD - 1;
  __syncthreads();
  SLOAD(SE, 0); asm volatile("s_waitcnt vmcnt(0)" ::: "memory"); SWRITE(0, SE); __syncthreads();
  qkt<NKS>(pA0, pA1, K_lds, qr, r32, hi, kcolB, 0.f); partialSM_first(pA0, pA1, m_reg, alA);
  SLOAD(SO, KVBLK); if constexpr (SD == 2) { if (2 < NT) SLOAD(SE, 2 * KVBLK); }
  SWAIT(); SWRITE(1, SO); __syncthreads();
  int bp = 0, bc = 1;
  for (int j = 1; j + 1 < NT; j += 2) {
    int bn = (bc == 2) ? 0 : bc + 1;
    SBAR(); qkt<NKS>(pB0, pB1, K_lds + bc * (int)SHM_K, qr, r32, hi, kcolB, -m_reg);
    finishSM(pA0, pA1, alA, l_reg, pa0, pa1, pa2, pa3); SBAR();
    SLOAD(SO, (j + SD) * KVBLK); SBAR();
    pv_sm(o, vb0 + bp * (int)SHM_V, pa0, pa1, pa2, pa3, pB0, pB1, m_reg, alB);
    SWAIT(); SWRITE(bn, SE);
    RESC(alB); __syncthreads();
    bp = bc; bc = bn; bn = (bc == 2) ? 0 : bc + 1;
    SBAR(); qkt<NKS>(pA0, pA1, K_lds + bc * (int)SHM_K, qr, r32, hi, kcolB, -m_reg);
    finishSM(pB0, pB1, alB, l_reg, pa0, pa1, pa2, pa3); SBAR();
    if (SD == 1 || j + 3 < NT) SLOAD(SE, (j + 1 + SD) * KVBLK); SBAR();
    pv_sm(o, vb0 + bp * (int)SHM_V, pa0, pa1, pa2, pa3, pA0, pA1, m_reg, alA);
    SWAIT(); SWRITE(bn, SO);
    RESC(alA); __syncthreads();
    bp = bc; bc = bn;
  }
  SBAR(); qkt<NKS>(pB0, pB1, K_lds + bc * (int)SHM_K, qr, r32, hi, kcolB, -m_reg);
  finishSM(pA0, pA1, alA, l_reg, pa0, pa1, pa2, pa3); SBAR();
  pv_sm(o, vb0 + bp * (int)SHM_V, pa0, pa1, pa2, pa3, pB0, pB1, m_reg, alB);
  RESC(alB);
  finishSM(pB0, pB1, alB, l_reg, pa0, pa1, pa2, pa3); SBAR();
  pv_d0(o, vb0 + bc * (int)SHM_V, pa0, pa1, pa2, pa3);
  if (hi == 0) li_l[r32] = l_reg; asm volatile("s_waitcnt lgkmcnt(0)" ::: "memory");
  float rli[16];
#pragma unroll
  for (int r = 0; r < 16; ++r) rli[r] = __builtin_amdgcn_rcpf(li_l[crow(r, hi)]);
  if (DIFF) {
    const int qw = wid & 3;
    float* X = (float*)lds;
    __syncthreads();
    if (mp == 1) {
#pragma unroll
      for (int r = 0; r < 16; ++r)
#pragma unroll
        for (int d0 = 0; d0 < 4; ++d0) X[(qw * 32 + crow(r, hi)) * 128 + d0 * 32 + r32] = o[d0][r] * rli[r];
    }
    __syncthreads();
    if (mp == 0) {
      float ss[16];
#pragma unroll
      for (int r = 0; r < 16; ++r) {
        float s2 = 0;
#pragma unroll
        for (int d0 = 0; d0 < 4; ++d0) { const float v = o[d0][r] * rli[r] - lam * X[(qw * 32 + crow(r, hi)) * 128 + d0 * 32 + r32]; o[d0][r] = v; s2 += v * v; }
        ss[r] = s2;
      }
#pragma unroll
      for (int r = 0; r < 16; ++r) {
#pragma unroll
        for (int m = 16; m >= 1; m >>= 1) ss[r] += __shfl_xor(ss[r], m);
      }
      float gs[4];
#pragma unroll
      for (int d0 = 0; d0 < 4; ++d0) gs[d0] = P.g_sub[layer * 128 + d0 * 32 + r32] * post;
#pragma unroll
      for (int r = 0; r < 16; ++r) {
        const float rs = rsqrtf(ss[r] * (1.f / 128.f) + EPS);
        const size_t tok = tok0 + crow(r, hi);
#pragma unroll
        for (int d0 = 0; d0 < 4; ++d0) {
          const size_t idx = tok * GW + hcol + d0 * 32 + r32;
          const float g = bf2f(P.GAp()[idx]);
          P.YAp()[idx] = f2bf(o[d0][r] * rs * gs[d0] * silu(g));
        }
      }
    }
    __syncthreads();
  } else {
#pragma unroll
    for (int r = 0; r < 16; ++r) {
      const size_t tok = tok0 + crow(r, hi);
#pragma unroll
      for (int d0 = 0; d0 < 4; ++d0) {
        const size_t idx = tok * GW + hcol + d0 * 32 + r32;
        const float g = bf2f(P.MGp()[idx]);
        P.GAp()[idx] = f2bf(o[d0][r] * rli[r] * silu(g));
      }
    }
    __syncthreads();
  }
#undef SLOAD
#undef SWRITE
#undef SWAIT
#undef RESC
}

__device__ __forceinline__ void phase_attn(const Params& P, int layer, char* lds, int TIDX, int BIDX) {
  const int wid = TIDX >> 6, lane = TIDX & 63, r32 = lane & 31, hi = lane >> 5;
  float d1 = P.lq1[layer * 64 + lane] * P.lk1[layer * 64 + lane], d2 = P.lq2[layer * 64 + lane] * P.lk2[layer * 64 + lane];
  d1 = wave_sum(d1); d2 = wave_sum(d2);
  const float lam_init = 0.8f - 0.6f * expf(-0.3f * (float)layer);
  const float lam = expf(d1) - expf(d2) + lam_init;
  const float post = 1.f - lam_init;
  const int nb = gridDim.x;
#pragma unroll 1
  for (int rep = 0; rep < REP_ATT; ++rep)
  for (int it = BIDX; it < 512; it += nb) {
    const int bh = it & 7, qb = it >> 3, b = bh >> 2, h = bh & 3;
    const int mp = wid >> 2, qw = wid & 3;
    const int tok0 = b * SEQ + qb * 128 + qw * 32;
    const u16* Qlane = P.Qp() + (size_t)(tok0 + r32) * GW + h * 128 + mp * 64 + hi * 8;
    const u16* Kh = P.Kp() + (size_t)(b * SEQ) * GW + h * 128;
    const u16* Vh = P.Vp() + (size_t)(b * SEQ) * GW + h * 128;
    attn_item<true>(P, layer, Qlane, Kh, Vh, SEQ, tok0, h * 128, lam, post, lds, TIDX);
  }
  if (layer == 0) {
    for (int it = BIDX; it < 16; it += nb) { const int r = it & 7; if (it < 8) gemm_tile<2>(P, 0, (r >> 2) * 256, (r & 3) * 256, lds, TIDX); else gemm_tile<2>(P, 1, (r >> 2) * 256, (r & 3) * 256, lds, TIDX); }
  }
}

__device__ __forceinline__ constexpr float CW(int k) {
  switch (k & 31) {
    case 0: return 1.f; case 1: return 0.98078528040323043f; case 2: return 0.92387953251128674f; case 3: return 0.83146961230254524f;
    case 4: return 0.70710678118654752f; case 5: return 0.55557023301960218f; case 6: return 0.38268343236508978f; case 7: return 0.19509032201612825f;
    case 8: return 0.f; case 9: return -0.19509032201612825f; case 10: return -0.38268343236508978f; case 11: return -0.55557023301960218f;
    case 12: return -0.70710678118654752f; case 13: return -0.83146961230254524f; case 14: return -0.92387953251128674f; case 15: return -0.98078528040323043f;
    default: return -1.f; }
}
__device__ __forceinline__ constexpr float SWc(int k) {
  switch (k & 31) {
    case 0: return 0.f; case 1: return 0.19509032201612825f; case 2: return 0.38268343236508978f; case 3: return 0.55557023301960218f;
    case 4: return 0.70710678118654752f; case 5: return 0.83146961230254524f; case 6: return 0.92387953251128674f; case 7: return 0.98078528040323043f;
    case 8: return 1.f; case 9: return 0.98078528040323043f; case 10: return 0.92387953251128674f; case 11: return 0.83146961230254524f;
    case 12: return 0.70710678118654752f; case 13: return 0.55557023301960218f; case 14: return 0.38268343236508978f; case 15: return 0.19509032201612825f;
    default: return 0.f; }
}
__device__ __forceinline__ constexpr int brev5(int p) { return ((p & 1) << 4) | ((p & 2) << 2) | (p & 4) | ((p & 8) >> 2) | ((p & 16) >> 4); }
__device__ __forceinline__ int fsw(int a) { return a ^ (((a >> 5) & 15) | (((a >> 9) & 1) << 4)); }

using f2 = __attribute__((ext_vector_type(2))) float;
__device__ __forceinline__ f2 cmul_neg(f2 d, float c, float s) { return d * c + f2{d[1], -d[0]} * s; }
__device__ __forceinline__ f2 cmul_pos(f2 d, float c, float s) { return d * c + f2{-d[1], d[0]} * s; }
template <int R, bool INV, int OFF>
__device__ __forceinline__ void fft_net(f2 (&x)[32]) {
  constexpr int LOGR = (R == 32) ? 5 : 4;
  if (!INV) {
#pragma unroll
    for (int lg = LOGR - 1; lg >= 0; --lg) {
      const int h = 1 << lg;
#pragma unroll
      for (int i = 0; i < R; ++i) {
        if (i & h) continue;
        const int k = (i & (h - 1)) * (16 / h);
        const f2 a = x[OFF + i], b = x[OFF + i + h];
        x[OFF + i] = a + b;
        const f2 d = a - b;
        if (k == 0) x[OFF + i + h] = d;
        else if (k == 8) x[OFF + i + h] = f2{d[1], -d[0]};
        else x[OFF + i + h] = cmul_neg(d, CW(k), SWc(k));
      }
    }
  } else {
#pragma unroll
    for (int lg = 0; lg < LOGR; ++lg) {
      const int h = 1 << lg;
#pragma unroll
      for (int i = 0; i < R; ++i) {
        if (i & h) continue;
        const int k = (i & (h - 1)) * (16 / h);
        const f2 a = x[OFF + i], B = x[OFF + i + h];
        f2 b;
        if (k == 0) b = B;
        else if (k == 8) b = f2{-B[1], B[0]};
        else b = cmul_pos(B, CW(k), SWc(k));
        x[OFF + i] = a + b; x[OFF + i + h] = a - b;
      }
    }
  }
}
template <bool INV, int LOGN>
__device__ __forceinline__ void twiddle32(f2 (&x)[32], int j) {
  asm volatile("" : "+v"(j));
  const float turns = (float)j * (1.f / (float)(1 << LOGN));
  const float c1 = __builtin_amdgcn_cosf(turns), s1 = __builtin_amdgcn_sinf(turns);
  const f2 w2 = {c1 * c1 - s1 * s1, 2.f * c1 * s1};
  f2 we = {1.f, 0.f}, wo = {c1, s1};
#pragma unroll
  for (int r = 1; r < 32; ++r) {
    f2 w;
    if (r & 1) { w = wo; wo = cmul_pos(wo, w2[0], w2[1]); }
    else { we = cmul_pos(we, w2[0], w2[1]); w = we; }
    const int p = brev5(r);
    x[p] = INV ? cmul_pos(x[p], w[0], w[1]) : cmul_neg(x[p], w[0], w[1]);
  }
}
__device__ __forceinline__ void fft_fwd_p0(f2 (&x)[32], f2* D, int t) {
  asm volatile("" : "+v"(t));
  fft_net<32, false, 0>(x);
  twiddle32<false, 14>(x, t);
  const int e0 = t ^ ((t >> 5) & 15), e1 = e0 ^ 16;
#pragma unroll
  for (int p = 0; p < 32; ++p) D[p * 512 + ((p & 1) ? e1 : e0)] = x[p];
}
__device__ __forceinline__ void fft_fwd_p1(f2 (&x)[32], f2* D, int t) {
  asm volatile("" : "+v"(t));
  const int j = t & 15, blk = t >> 4, b0 = blk * 512 + ((blk & 1) << 4), b1 = b0 ^ 16;
#pragma unroll
  for (int q = 0; q < 32; ++q) x[q] = D[((q & 1) ? b1 : b0) + (q >> 1) * 32 + (j ^ (q >> 1))];
  fft_net<32, false, 0>(x);
  twiddle32<false, 9>(x, j);
#pragma unroll
  for (int p = 0; p < 32; ++p) D[((p & 1) ? b1 : b0) + (p >> 1) * 32 + (j ^ (p >> 1))] = x[p];
}
__device__ __forceinline__ void fft_p2_load(f2 (&x)[32], f2* D, int t) {
  asm volatile("" : "+v"(t));
#pragma unroll
  for (int u = 0; u < 2; ++u) {
    const int B = u * 512 + t, hb = (B * 16) ^ (((B >> 5) & 1) << 4), m4 = (B >> 1) & 15;
#pragma unroll
    for (int q = 0; q < 16; ++q) x[u * 16 + q] = D[hb + (q ^ m4)];
  }
  fft_net<16, false, 0>(x); fft_net<16, false, 16>(x);
}
__device__ __forceinline__ void fft_p2_inv_store(f2 (&x)[32], f2* D, int t) {
  asm volatile("" : "+v"(t));
  fft_net<16, true, 0>(x); fft_net<16, true, 16>(x);
#pragma unroll
  for (int u = 0; u < 2; ++u) {
    const int B = u * 512 + t, hb = (B * 16) ^ (((B >> 5) & 1) << 4), m4 = (B >> 1) & 15;
#pragma unroll
    for (int q = 0; q < 16; ++q) D[hb + (q ^ m4)] = x[u * 16 + q];
  }
}
__device__ __forceinline__ void fft_inv_p1(f2 (&x)[32], f2* D, int t) {
  asm volatile("" : "+v"(t));
  const int j = t & 15, blk = t >> 4, b0 = blk * 512 + ((blk & 1) << 4), b1 = b0 ^ 16;
#pragma unroll
  for (int q = 0; q < 32; ++q) x[q] = D[((q & 1) ? b1 : b0) + (q >> 1) * 32 + (j ^ (q >> 1))];
  twiddle32<true, 9>(x, j);
  fft_net<32, true, 0>(x);
#pragma unroll
  for (int p = 0; p < 32; ++p) D[((p & 1) ? b1 : b0) + (p >> 1) * 32 + (j ^ (p >> 1))] = x[p];
}
__device__ __forceinline__ void fft_inv_p0(f2 (&x)[32], f2* D, int t) {
  asm volatile("" : "+v"(t));
  const int e0 = t ^ ((t >> 5) & 15), e1 = e0 ^ 16;
#pragma unroll
  for (int q = 0; q < 32; ++q) x[q] = D[q * 512 + ((q & 1) ? e1 : e0)];
  twiddle32<true, 14>(x, t);
  fft_net<32, true, 0>(x);
}

__device__ __forceinline__ float sc_val(const u16* __restrict__ hy, int s, float w0, float w1, float w2, float bias) {
  const int sl = s > 0 ? s - 1 : 0, sr2 = s < SEQ - 1 ? s + 1 : SEQ - 1;
  const float c = bf2f(hy[s]);
  const float l = bf2f(hy[sl]) * (s > 0 ? 1.f : 0.f);
  const float r = bf2f(hy[sr2]) * (s < SEQ - 1 ? 1.f : 0.f);
  return w0 * l + w1 * c + w2 * r + bias;
}

__device__ __forceinline__ void hyena_channel(const Params& P, int layer, int c, char* lds, int TIDX, int BIDX) {
  f2* D = (f2*)lds; float* kcl = (float*)lds; float* wl = (float*)(lds + 131072);
  int t = TIDX; asm volatile("" : "+v"(t));
  const float* cw = P.conv_w + (size_t)layer * 3 * 1536; const float* cb = P.conv_b + (size_t)layer * 1536;
  const u16* hy0 = P.HYTp(); const u16* hy1 = P.HYTp() + (size_t)2048 * SEQ;
  const float min_decay = -3.0701134573253944f, max_decay = -15.350567286626972f;
  const float dF = fabsf(min_decay + (max_decay - min_decay) * ((float)c / 511.f));
  const float dB = fabsf(min_decay + (max_decay - min_decay) * ((float)(511 - c) / 511.f));
  typedef _Float16 h2_t __attribute__((ext_vector_type(2)));
  h2_t* KFH = reinterpret_cast<h2_t*>(P.Kp()) + (size_t)BIDX * 32768 + t * 32;
  {
    float* kcl1 = (float*)(lds + 65536);
    __syncthreads();
    {
      int tf = t; asm volatile("" : "+v"(tf));
      const int lane = tf & 63, r32 = lane & 31, hi = lane >> 5, wv = tf >> 6;
      bf16x8 af[4];
#pragma unroll
      for (int ks = 0; ks < 4; ++ks) {
        float wv8[8];
#pragma unroll
        for (int i = 0; i < 8; ++i) {
          const int rr = r32 & 3;
          const float x = P.hf_w4[((size_t)layer * 64 + ks * 16 + hi * 8 + i) * 2048 + (rr >> 1) * 1024 + (rr & 1) * 512 + c];
          wv8[i] = (r32 < 4) ? x : 0.f;
        }
        u32x4 w = {cvtpk(wv8[0], wv8[1]), cvtpk(wv8[2], wv8[3]), cvtpk(wv8[4], wv8[5]), cvtpk(wv8[6], wv8[7])};
        af[ks] = *reinterpret_cast<bf16x8*>(&w);
      }
      const u16* hb = reinterpret_cast<const u16*>(P.hdnp()) + ((size_t)layer * SEQ + wv * 1024 + r32) * 64 + hi * 8;
#pragma unroll 1
      for (int g = 0; g < 4; ++g) {
        bf16x8 bfr[8][4];
#pragma unroll
        for (int pb = 0; pb < 8; ++pb)
#pragma unroll
          for (int ks = 0; ks < 4; ++ks) bfr[pb][ks] = *reinterpret_cast<const bf16x8*>(hb + (size_t)((g * 8 + pb) * 32) * 64 + ks * 16);
#pragma unroll
        for (int pb = 0; pb < 8; ++pb) {
          f32x16 acc = f32x16{};
#pragma unroll
          for (int ks = 0; ks < 4; ++ks) acc = __builtin_amdgcn_mfma_f32_32x32x16_bf16(af[ks], bfr[pb][ks], acc, 0, 0, 0);
          if (hi == 0) {
            const int tt = wv * 1024 + (g * 8 + pb) * 32 + r32; const float tl = (float)tt * (1.f / 8191.f);
            const float ef = __expf(-tl * dF), eb = (tt == SEQ - 1) ? 0.f : __expf(-tl * dB);
            kcl[tt] = acc[0] * ef; kcl[16383 - tt] = acc[1] * eb;
            kcl1[tt] = acc[2] * ef; kcl1[16383 - tt] = acc[3] * eb;
          }
        }
      }
    }
    __syncthreads();
    f2 x[32];
#pragma unroll
    for (int q = 0; q < 32; ++q) x[q] = f2{kcl[q * 512 + t], kcl1[q * 512 + t]};
    __syncthreads();
    fft_fwd_p0(x, D, t); __syncthreads();
    fft_fwd_p1(x, D, t); __syncthreads();
    fft_p2_load(x, D, t);
    {
      int tx = t; asm volatile("" : "+v"(tx));
#pragma unroll
      for (int u = 0; u < 2; ++u) {
        const int B = u * 512 + tx, hb = (B * 16) ^ (((B >> 5) & 1) << 4), m4 = (B >> 1) & 15;
#pragma unroll
        for (int q = 0; q < 16; ++q) D[hb + (q ^ m4)] = x[u * 16 + q];
      }
      __syncthreads();
#pragma unroll
      for (int u = 0; u < 2; ++u)
#pragma unroll
        for (int q = 0; q < 16; ++q) {
          const unsigned a = (unsigned)((u * 512 + tx) * 16 + q);
          const unsigned kfreq = __builtin_bitreverse32(a) >> 18;
          const unsigned ap = __builtin_bitreverse32((16384u - kfreq) & 16383u) >> 18;
          const f2 v = D[fsw((int)ap)];
          const float wr = x[u * 16 + q][0], wi = x[u * 16 + q][1];
          h2_t k0 = {(_Float16)(0.5f * (wr + v[0])), (_Float16)(0.5f * (wi - v[1]))};
          h2_t k1 = {(_Float16)(0.5f * (wi + v[1])), (_Float16)(0.5f * (v[0] - wr))};
          KFH[u * 16 + q] = k0; KFH[16384 + u * 16 + q] = k1;
        }
    }
  }
  float zr[16], zi[16];
  {
    const float w0 = cw[c], w1 = cw[1536 + c], w2 = cw[3072 + c], bb = cb[c];
#pragma unroll
    for (int q = 0; q < 16; ++q) { const int s = q * 512 + t; zr[q] = sc_val(hy0 + (size_t)c * SEQ, s, w0, w1, w2, bb); zi[q] = sc_val(hy1 + (size_t)c * SEQ, s, w0, w1, w2, bb); if ((q & 3) == 3) SBAR(); }
  }
#pragma unroll 1
  for (int order = 0; order < 2; ++order) {
    const h2_t* KF = KFH + order * 16384;
    f2 x[32];
#pragma unroll
    for (int q = 0; q < 16; ++q) { x[q] = f2{zr[q], zi[q]}; x[q + 16] = f2{0.f, 0.f}; }
    __syncthreads();
    fft_fwd_p0(x, D, t); __syncthreads();
    fft_fwd_p1(x, D, t); __syncthreads();
    fft_p2_load(x, D, t);
#pragma unroll
    for (int q = 0; q < 32; ++q) { const h2_t kh = KF[q]; const float k0 = (float)kh[0] * (1.f / 16384.f), k1 = (float)kh[1] * (1.f / 16384.f); x[q] = cmul_pos(x[q], k0, k1); }
    fft_p2_inv_store(x, D, t); __syncthreads();
    fft_inv_p1(x, D, t); __syncthreads();
    fft_inv_p0(x, D, t);
    int te = t; asm volatile("" : "+v"(te));
    const float skip = P.hy_skip[((size_t)layer * 2 + order) * 512 + c];
    const int xc = (order == 0 ? 512 : 1024) + c;
    const float w0 = cw[xc], w1 = cw[1536 + xc], w2 = cw[3072 + xc], bb = cb[xc];
    if (order == 0) {
#pragma unroll
      for (int q = 0; q < 16; ++q) {
        const int s = q * 512 + te;
        const float x0 = sc_val(hy0 + (size_t)xc * SEQ, s, w0, w1, w2, bb), x1 = sc_val(hy1 + (size_t)xc * SEQ, s, w0, w1, w2, bb);
        zr[q] = x0 * (x[q][0] + skip * zr[q]); zi[q] = x1 * (x[q][1] + skip * zi[q]);
        if ((q & 3) == 3) SBAR();
      }
    } else {
#pragma unroll
      for (int q = 0; q < 16; ++q) {
        const int s = q * 512 + te;
        const float x0 = sc_val(hy0 + (size_t)xc * SEQ, s, w0, w1, w2, bb), x1 = sc_val(hy1 + (size_t)xc * SEQ, s, w0, w1, w2, bb);
        const float g0 = bf2f(hy0[(size_t)(1536 + c) * SEQ + s]), g1 = bf2f(hy1[(size_t)(1536 + c) * SEQ + s]);
        P.YBp()[(size_t)s * GW + c] = f2bf(x0 * (x[q][0] + skip * zr[q]) * silu(g0));
        P.YBp()[(size_t)(SEQ + s) * GW + c] = f2bf(x1 * (x[q][1] + skip * zi[q]) * silu(g1));
        if ((q & 3) == 3) SBAR();
      }
    }
  }
}

__device__ __forceinline__ void phase_hyena_cross(const Params& P, int layer, char* lds, int TIDX, int BIDX) {
  const int nb = gridDim.x;
#pragma unroll 1
  for (int rep = 0; rep < REP_HY; ++rep)
  for (int ci = BIDX; ci < GW; ci += nb) {
    const int c = (nb == 256) ? 64 * (BIDX & 7) + 2 * (BIDX >> 3) + (ci >> 8) : ci;
    hyena_channel(P, layer, c, lds, TIDX, BIDX);
  }
  __syncthreads();
  const int wid = TIDX >> 6, lane = TIDX & 63, r32 = lane & 31, hi = lane >> 5;
#pragma unroll 1
  for (int rep = 0; rep < REP_CROSS; ++rep)
  for (int it = BIDX; it < 256; it += nb) {
    const int h = it & 3, blk = it >> 2;
    const int tok0 = blk * 256 + wid * 32, b = tok0 >> 13;
    const u16* Qlane = P.MQp() + (size_t)(tok0 + r32) * GW + h * 128 + hi * 8;
    const u16* Kh = P.MemKVp() + ((size_t)layer * NB * MEML + b * MEML) * DM + h * 128;
    attn_item<false>(P, layer, Qlane, Kh, Kh + GW, MEML, tok0, h * 128, 0.f, 1.f, lds, TIDX);
  }
}

template <int PH>
__device__ __forceinline__ void run_phase(const Params& P, char* lds, int wave_s) {
  int TIDX = (wave_s << 6) | (int)__builtin_amdgcn_mbcnt_hi(~0u, __builtin_amdgcn_mbcnt_lo(~0u, 0u)); asm volatile("" : "+v"(TIDX));
  int BIDX = blockIdx.x; asm volatile("" : "+s"(BIDX));
  const int nb = gridDim.x, bid = BIDX;
  if constexpr (PH == 0) {
#pragma unroll 1
    for (int rep = 0; rep < REP_PREP; ++rep) phase_prep(P, lds, TIDX, BIDX); }
  else {
    constexpr int layer = (PH - 1) / 5, sub = (PH - 1) % 5;
    if constexpr (sub == 0) {
#pragma unroll 1
      for (int rep = 0; rep < REP_PROJ; ++rep)
      { bool pre = false;
        for (int it = bid; it < 64 * 20; it += nb) { const int tn = it >> 6, tm = it & 63; const int nx = it + nb; const bool hn = nx < 64 * 20;
          gemm_tile<0>(P, layer, tm * 256, tn * 256, lds, TIDX, pre, hn ? (nx & 63) * 256 : -1, hn ? (nx >> 6) * 256 : 0); pre = hn; } }
    } else if constexpr (sub == 1) {
      phase_attn(P, layer, lds, TIDX, BIDX);
    } else if constexpr (sub == 2) {
      phase_hyena_cross(P, layer, lds, TIDX, BIDX);
    } else if constexpr (sub == 3) {
#pragma unroll 1
      for (int rep = 0; rep < (layer == 0 ? REP_OUT0 : 1); ++rep)
      for (int it = bid; it < 64 * 4; it += nb) { const int tn = it >> 6, tm = it & 63; gemm_tile<1>(P, layer, tm * 256, tn * 256, lds, TIDX); }
    } else {
      const int wid = TIDX >> 6, lane = TIDX & 63;
      if constexpr (layer == 0) {
#pragma unroll 1
        for (int rep = 0; rep < REP_NORM0; ++rep)
        for (int it = bid; it < NTOK / 8; it += nb) { const int row = it * 8 + wid; norm_row_bf16(P.out + (size_t)row * DM, P.g_norm + DM, P.Hp() + (size_t)row * DM, lane); }
      } else {
        for (int it = bid; it < NTOK / 8; it += nb) { const int row = it * 8 + wid; norm_row_f32(P.out + (size_t)row * DM, P.g_final, lane); }
      }
    }
  }
}

#define XB_TMO      128
#define XB_XCNT(j)  (256  + 64 * (j))
#define XB_XSUB(j)  (1280 + 64 * (j))
#define XB_XGEN(j)  (2304 + 64 * (j))
#define XB_TOP      3328
#define XB_TOPGEN   3392
#define XCD_BAR_WORDS 3456
#define XB_SPIN_CAP (1u << 18)
#define LAS __attribute__((address_space(3)))

__device__ __forceinline__ unsigned xb_ld(unsigned* p)              { return __hip_atomic_load(p, __ATOMIC_RELAXED, __HIP_MEMORY_SCOPE_AGENT); }
__device__ __forceinline__ unsigned xb_add(unsigned* p, unsigned v) { return __hip_atomic_fetch_add(p, v, __ATOMIC_RELAXED, __HIP_MEMORY_SCOPE_AGENT); }
__device__ __forceinline__ unsigned xb_xcc_id() { return (unsigned)__builtin_amdgcn_s_getreg((3 << 11) | 20) & 0xFu; }
#define XB_SPIN(cond, bar) do { unsigned _sp = 0; while (cond) { __builtin_amdgcn_s_sleep(1); \
    if ((++_sp & 255u) == 0u) { if (xb_ld(&(bar)[XB_TMO])) break; if (_sp > XB_SPIN_CAP) { atomicAdd(&(bar)[XB_TMO], 1u); break; } } } } while (0)

struct XcdBarrier {
    unsigned* bar; unsigned x;
    volatile LAS unsigned* st;
};

__device__ __forceinline__ XcdBarrier xcd_barrier_post(unsigned* bar, volatile LAS unsigned* st) {
    XcdBarrier b; b.bar = bar; b.x = xb_xcc_id(); b.st = st;
    if (threadIdx.x == 0) (void)xb_add(&bar[XB_XCNT(b.x)], 1u);
    return b;
}
__device__ __forceinline__ void xcd_barrier_complete(unsigned* bar, unsigned x, unsigned& nloc, unsigned& nx) {
    const unsigned G = gridDim.x * gridDim.y * gridDim.z;
    unsigned sum, cnt, mine, sp = 0u;
    for (;;) {
        sum = 0u; cnt = 0u; mine = 0u;
#pragma unroll
        for (unsigned j = 0; j < 16; ++j) { const unsigned c = xb_ld(&bar[XB_XCNT(j)]); sum += c; cnt += (c > 0u) ? 1u : 0u; mine = (j == x) ? c : mine; }
        if (sum == G) break;
        __builtin_amdgcn_s_sleep(1);
        if ((++sp & 255u) == 0u) { if (xb_ld(&bar[XB_TMO])) break; if (sp > XB_SPIN_CAP) { atomicAdd(&bar[XB_TMO], 1u); break; } }
    }
    nloc = mine > 0u ? mine : 1u; nx = cnt > 0u ? cnt : 1u;
}

__device__ __forceinline__ void xcd_barrier(const XcdBarrier& b) {
    asm volatile("s_waitcnt vmcnt(0)" ::: "memory");
    __syncthreads();
    if (threadIdx.x == 0) {
        unsigned* bar = b.bar;
        __builtin_amdgcn_s_waitcnt(0);
        unsigned nloc = b.st[0], nx = b.st[1];
        if (nloc == 0u) { xcd_barrier_complete(bar, b.x, nloc, nx); b.st[0] = nloc; b.st[1] = nx; }
        const unsigned old = xb_add(&bar[XB_XSUB(b.x)], 1u);
        const unsigned gen = old / nloc;
        if (old + 1u == (gen + 1u) * nloc) {
            __builtin_amdgcn_fence(__ATOMIC_RELEASE, "agent");
            asm volatile("s_waitcnt vmcnt(0)" ::: "memory");
            const unsigned og = xb_add(&bar[XB_TOP], 1u);
            const unsigned tg = og / nx;
            if (og + 1u == (tg + 1u) * nx) xb_add(&bar[XB_TOPGEN], 1u);
            else XB_SPIN(xb_ld(&bar[XB_TOPGEN]) == tg, bar);
            __builtin_amdgcn_fence(__ATOMIC_ACQUIRE, "agent");
            xb_add(&bar[XB_XGEN(b.x)], 1u);
            asm volatile("s_waitcnt vmcnt(0)" ::: "memory");
        } else {
            XB_SPIN(xb_ld(&bar[XB_XGEN(b.x)]) == gen, bar);
            __builtin_amdgcn_fence(__ATOMIC_ACQUIRE, "agent");
            asm volatile("s_waitcnt vmcnt(0)" ::: "memory");
        }
    }
    __syncthreads();
}

template <bool SINGLE>
__global__ __launch_bounds__(512) void mega(Params P) {
  extern __shared__ __attribute__((aligned(16))) char lds[];
  const int wave_s = __builtin_amdgcn_readfirstlane((int)threadIdx.x >> 6);
  if constexpr (SINGLE) {
    cg::grid_group grid = cg::this_grid();
    __shared__ unsigned xb_st[4];
    if (threadIdx.x < 4) xb_st[threadIdx.x] = 0u;
    __syncthreads();
    const XcdBarrier xb = xcd_barrier_post((unsigned*)(P.ws + (size_t)232 * 1048576), (volatile LAS unsigned*)xb_st);
    if (P.phase_hi < 0) grid.sync();
    run_phase<0>(P, lds, wave_s); xcd_barrier(xb);
    run_phase<1>(P, lds, wave_s); xcd_barrier(xb);
    run_phase<2>(P, lds, wave_s); xcd_barrier(xb);
    run_phase<3>(P, lds, wave_s); xcd_barrier(xb);
    run_phase<4>(P, lds, wave_s); xcd_barrier(xb);
    run_phase<5>(P, lds, wave_s); xcd_barrier(xb);
    run_phase<6>(P, lds, wave_s); xcd_barrier(xb);
    run_phase<7>(P, lds, wave_s); xcd_barrier(xb);
    run_phase<8>(P, lds, wave_s); xcd_barrier(xb);
    run_phase<9>(P, lds, wave_s); xcd_barrier(xb);
    run_phase<10>(P, lds, wave_s);
  } else {
    switch (P.phase_lo) {
      case 0: run_phase<0>(P, lds, wave_s); break;
      case 1: run_phase<1>(P, lds, wave_s); break;
      case 2: run_phase<2>(P, lds, wave_s); break;
      case 3: run_phase<3>(P, lds, wave_s); break;
      case 4: run_phase<4>(P, lds, wave_s); break;
      case 5: run_phase<5>(P, lds, wave_s); break;
      case 6: run_phase<6>(P, lds, wave_s); break;
      case 7: run_phase<7>(P, lds, wave_s); break;
      case 8: run_phase<8>(P, lds, wave_s); break;
      case 9: run_phase<9>(P, lds, wave_s); break;
      default: run_phase<10>(P, lds, wave_s); break;
    }
  }
}

extern "C" void kernel_launch(void* const* d_in, const int* in_sizes, int n_in, void* d_out, int out_size, void* d_ws, size_t ws_size, hipStream_t stream) {
  static int grid = 0;
  if (grid == 0) {
    int dev = 0, cus = 0, per_cu = 0;
    hipGetDevice(&dev);
    hipDeviceGetAttribute(&cus, hipDeviceAttributeMultiprocessorCount, dev);
    if (hipFuncSetAttribute((const void*)MEGA, hipFuncAttributeMaxDynamicSharedMemorySize, LDS_BYTES) != hipSuccess) { fprintf(stderr, "hipFuncSetAttribute failed\n"); grid = -1; return; }
    hipOccupancyMaxActiveBlocksPerMultiprocessor(&per_cu, (const void*)MEGA, 512, LDS_BYTES);
    (void)hipGetLastError();
    (void)per_cu;
    grid = cus < 256 ? cus : 256;
  }
  if (grid < 0) return;
  Params p{};
  const float** f = (const float**)&p.x;
  for (int i = 0; i < 24; ++i) f[i] = (const float*)d_in[i];
  p.out = (float*)d_out;
  p.ws = (char*)d_ws;
#if ONE_LAUNCH
  p.phase_lo = 0; p.phase_hi = NPHASE;
  hipMemsetAsync((char*)d_ws + (size_t)232 * 1048576, 0, 16384, stream);
  void* args[] = {&p};
  hipError_t e = hipLaunchCooperativeKernel((const void*)MEGA, dim3(grid), dim3(512), args, LDS_BYTES, stream);
  if (e != hipSuccess) fprintf(stderr, "cooperative launch failed: %s (grid %d)\n", hipGetErrorString(e), grid);
#else
  for (int ph = 0; ph < NPHASE; ++ph) {
    p.phase_lo = ph; p.phase_hi = ph + 1;
    hipLaunchKernelGGL(MEGA, dim3(grid), dim3(512), LDS_BYTES, stream, p);
  }
#endif
}
```

```cpp
#include <hip/hip_runtime.h>
#include <hip/hip_bf16.h>
#include <hip/hip_cooperative_groups.h>
#include <cstdio>
#include <cstdint>
namespace cg = cooperative_groups;

typedef unsigned short u16;
using bf16x8 = __attribute__((ext_vector_type(8))) short;
using s16x4  = __attribute__((ext_vector_type(4))) short;
using f32x16 = __attribute__((ext_vector_type(16))) float;
using f32x4  = __attribute__((ext_vector_type(4))) float;
using u32x4  = __attribute__((ext_vector_type(4))) unsigned;
using u32x2  = __attribute__((ext_vector_type(2))) unsigned;

constexpr int DM = 1024, NB = 2, SEQ = 8192, NTOK = NB * SEQ, DEPTH = 2;
constexpr int GW = 512, DIN = 5120, DMIX = 1536, MEML = 256;
constexpr float EPS = 1e-6f;
constexpr int NPHASE = 11;
#define REP_HY 1
#define REP_OUT0 1
#define REP_CROSS 1
#define REP_NORM0 1
#define REP_ATT 1
#define REP_PROJ 1
#define REP_PREP 1
#ifndef ONE_LAUNCH
#define ONE_LAUNCH 1
#endif
#define MEGA mega<(ONE_LAUNCH != 0)>
#define MEGA mega<(ONE_LAUNCH != 0)>
#ifndef DBG_SKIP_MIX
#define DBG_SKIP_MIX 0
#endif
#ifndef DBG_NPH
#define DBG_NPH 11
#endif
#ifndef DBG_KT_LO
#define DBG_KT_LO 0
#endif
#ifndef DBG_KT_HI
#define DBG_KT_HI 24
#endif
constexpr int LDS_BYTES = 131072 + 1024;

struct Params {
  const float *x, *mem, *g_norm, *w_in, *lq1, *lk1, *lq2, *lk2, *g_sub, *conv_w, *conv_b;
  const float *hf_w1, *hf_b1, *hf_w2, *hf_b2, *hf_w3, *hf_b3, *hf_w4, *hf_freq, *hy_skip, *g_mem, *w_mem_kv, *w_out, *g_final;
  float* out;
  char* ws;
  int phase_lo, phase_hi;
#define WSF(name, type, mib) __device__ __forceinline__ type* name() const { return (type*)(ws + (size_t)(mib) * 1048576); }
  WSF(Qp, u16, 0) WSF(Kp, u16, 16) WSF(Vp, u16, 32) WSF(GAp, u16, 48) WSF(MQp, u16, 64) WSF(MGp, u16, 80) WSF(HYTp, u16, 96)
  WSF(Hp, u16, 160) WSF(YBp, u16, 160) WSF(YAp, u16, 176) WSF(WinTp, u16, 192) WSF(WoutTp, u16, 212) WSF(WmTp, u16, 218) WSF(Mnp, u16, 222) WSF(MemKVp, u16, 224)
  WSF(hdnp, float, 226) WSF(ropeCp, float, 230) WSF(ropeSp, float, 231)
#undef WSF
};

#define SBAR() __builtin_amdgcn_sched_barrier(0)
__device__ __forceinline__ int crow(int r, int hi) { return (r & 3) + 8 * (r >> 2) + 4 * hi; }
typedef __bf16 bf2_t __attribute__((ext_vector_type(2)));
typedef float fl2_t __attribute__((ext_vector_type(2)));
__device__ __forceinline__ unsigned cvtpk(float lo, float hi) {
  fl2_t f = {lo, hi};
  bf2_t b = __builtin_convertvector(f, bf2_t);
  return __builtin_bit_cast(unsigned, b);
}
__device__ __forceinline__ u16 f2bf(float x) { return __builtin_bit_cast(u16, (__bf16)x); }
__device__ __forceinline__ float bf2f(u16 v) { return __uint_as_float(((unsigned)v) << 16); }
__device__ __forceinline__ float silu(float x) { return x / (1.f + __expf(-x)); }
__device__ __forceinline__ float wave_sum(float v) {
  for (int m = 32; m >= 1; m >>= 1) v += __shfl_xor(v, m);
  return v;
}

__device__ __forceinline__ void transpose_tile(const float* __restrict__ W, u16* __restrict__ WT, int Kd, int Nd, int tk, int tn, char* lds, int TIDX) {
  u16* tile = (u16*)lds;
  const int tid = TIDX;
  const int kr = tid >> 4, nc = (tid & 15) * 4;
  __syncthreads();
#pragma unroll
  for (int i = 0; i < 2; ++i) {
    const int k = kr + 32 * i;
    const f32x4 v = *reinterpret_cast<const f32x4*>(W + (size_t)(tk * 64 + k) * Nd + tn * 64 + nc);
#pragma unroll
    for (int j = 0; j < 4; ++j) tile[(nc + j) * 72 + k] = f2bf(v[j]);
  }
  __syncthreads();
  const int n = tid >> 3, kc = (tid & 7) * 8;
  const u32x4 o = *reinterpret_cast<const u32x4*>(tile + n * 72 + kc);
  *reinterpret_cast<u32x4*>(WT + (size_t)(tn * 64 + n) * Kd + tk * 64 + kc) = o;
}

__device__ __forceinline__ void norm_row_bf16(const float* __restrict__ xr, const float* __restrict__ g, u16* __restrict__ o, int lane) {
  f32x4 v[4]; float ss = 0;
#pragma unroll
  for (int i = 0; i < 4; ++i) { v[i] = *reinterpret_cast<const f32x4*>(xr + i * 256 + lane * 4); ss += v[i][0] * v[i][0] + v[i][1] * v[i][1] + v[i][2] * v[i][2] + v[i][3] * v[i][3]; }
  ss = wave_sum(ss);
  const float rs = rsqrtf(ss * (1.f / 1024.f) + EPS);
#pragma unroll
  for (int i = 0; i < 4; ++i) {
    const f32x4 gg = *reinterpret_cast<const f32x4*>(g + i * 256 + lane * 4);
    u32x2 w = {cvtpk(v[i][0] * rs * gg[0], v[i][1] * rs * gg[1]), cvtpk(v[i][2] * rs * gg[2], v[i][3] * rs * gg[3])};
    *reinterpret_cast<u32x2*>(o + i * 256 + lane * 4) = w;
  }
}
__device__ __forceinline__ void norm_row_f32(float* __restrict__ xr, const float* __restrict__ g, int lane) {
  f32x4 v[4]; float ss = 0;
#pragma unroll
  for (int i = 0; i < 4; ++i) { v[i] = *reinterpret_cast<const f32x4*>(xr + i * 256 + lane * 4); ss += v[i][0] * v[i][0] + v[i][1] * v[i][1] + v[i][2] * v[i][2] + v[i][3] * v[i][3]; }
  ss = wave_sum(ss);
  const float rs = rsqrtf(ss * (1.f / 1024.f) + EPS);
#pragma unroll
  for (int i = 0; i < 4; ++i) {
    const f32x4 gg = *reinterpret_cast<const f32x4*>(g + i * 256 + lane * 4);
    f32x4 w = {v[i][0] * rs * gg[0], v[i][1] * rs * gg[1], v[i][2] * rs * gg[2], v[i][3] * rs * gg[3]};
    *reinterpret_cast<f32x4*>(xr + i * 256 + lane * 4) = w;
  }
}

__device__ __forceinline__ void phase_prep(const Params& P, char* lds, int TIDX, int BIDX) {
  const int tid = TIDX, wid = tid >> 6, lane = tid & 63;
  const int nb = gridDim.x, bid = BIDX;
  {
    constexpr int U_IN = (DIN / 512) * (DM / 32), U_OUT = (DM / 512) * (DMIX / 32), U_M = (DM / 512) * (DM / 32);
    constexpr int U_L = U_IN + U_OUT + U_M;
    for (int it = bid; it < DEPTH * U_L; it += nb) {
      const int l = it / U_L; int r = it % U_L;
      const float* W; u16* WT; int Kd, Nd;
      if (r < U_IN) { W = P.w_in + (size_t)l * DM * DIN; WT = P.WinTp() + (size_t)l * DIN * DM; Kd = DM; Nd = DIN; }
      else if (r < U_IN + U_OUT) { r -= U_IN; W = P.w_out + (size_t)l * DMIX * DM; WT = P.WoutTp() + (size_t)l * DM * DMIX; Kd = DMIX; Nd = DM; }
      else { r -= U_IN + U_OUT; W = P.w_mem_kv + (size_t)l * DM * DM; WT = P.WmTp() + (size_t)l * DM * DM; Kd = DM; Nd = DM; }
      const int nkb = Kd / 32, nblk = r / nkb, kb = r % nkb;
      const int n = nblk * 512 + tid, k0 = kb * 32;
      const float* src = W + (size_t)k0 * Nd + n;
      float v[32];
#pragma unroll
      for (int k = 0; k < 32; ++k) v[k] = src[(size_t)k * Nd];
      u16* dst = WT + (size_t)n * Kd + k0;
#pragma unroll
      for (int c = 0; c < 4; ++c) {
        u32x4 o = {cvtpk(v[c * 8 + 0], v[c * 8 + 1]), cvtpk(v[c * 8 + 2], v[c * 8 + 3]), cvtpk(v[c * 8 + 4], v[c * 8 + 5]), cvtpk(v[c * 8 + 6], v[c * 8 + 7])};
        *reinterpret_cast<u32x4*>(dst + c * 8) = o;
      }
    }
  }
  for (int it = bid; it < NTOK / 8; it += nb) { const int row = it * 8 + wid; norm_row_bf16(P.x + (size_t)row * DM, P.g_norm, P.Hp() + (size_t)row * DM, lane); }
  for (int it = bid; it < DEPTH * NB * MEML / 8; it += nb) {
    const int r = it * 8 + wid, l = r / (NB * MEML), row = r % (NB * MEML);
    norm_row_bf16(P.mem + (size_t)row * DM, P.g_mem + l * DM, P.Mnp() + (size_t)r * DM, lane);
  }
  for (int gg = bid * 8 + wid; gg < DEPTH * SEQ / 8; gg += nb * 8) {
    const int r0 = gg * 8, l = r0 / SEQ, t0 = r0 % SEQ;
    float zf[8];
#pragma unroll
    for (int r = 0; r < 8; ++r) {
      const int tt = t0 + r; float z = 0.f;
      if (lane == 0) z = (float)tt * (1.f / 8191.f);
      else if (lane < 33) {
        const int i = (lane - 1) & 15;
        const float f = 1e-4f + (float)i * ((15.f - 1e-4f) / 15.f);
        const float w = (6.283185307179586f * (float)tt) / 8192.f;
        z = (lane <= 16) ? cosf(f * w) : -sinf(f * w);
      }
      zf[r] = z;
    }
    const float fr = P.hf_freq[l * 64 + lane];
    float a[8], h[8];
    { const float b = P.hf_b1[l * 64 + lane];
#pragma unroll
      for (int r = 0; r < 8; ++r) a[r] = b; }
#pragma unroll 3
    for (int i = 0; i < 33; ++i) { const float w = P.hf_w1[(l * 33 + i) * 64 + lane];
#pragma unroll
      for (int r = 0; r < 8; ++r) a[r] += __int_as_float(__builtin_amdgcn_readlane(__float_as_int(zf[r]), i)) * w; }
#pragma unroll
    for (int r = 0; r < 8; ++r) h[r] = sinf(fr * a[r]);
    { const float b = P.hf_b2[l * 64 + lane];
#pragma unroll
      for (int r = 0; r < 8; ++r) a[r] = b; }
#pragma unroll 4
    for (int i = 0; i < 64; ++i) { const float w = P.hf_w2[(l * 64 + i) * 64 + lane];
#pragma unroll
      for (int r = 0; r < 8; ++r) a[r] += __int_as_float(__builtin_amdgcn_readlane(__float_as_int(h[r]), i)) * w; }
#pragma unroll
    for (int r = 0; r < 8; ++r) h[r] = sinf(fr * a[r]);
    { const float b = P.hf_b3[l * 64 + lane];
#pragma unroll
      for (int r = 0; r < 8; ++r) a[r] = b; }
#pragma unroll 4
    for (int i = 0; i < 64; ++i) { const float w = P.hf_w3[(l * 64 + i) * 64 + lane];
#pragma unroll
      for (int r = 0; r < 8; ++r) a[r] += __int_as_float(__builtin_amdgcn_readlane(__float_as_int(h[r]), i)) * w; }
    u16* o = reinterpret_cast<u16*>(P.hdnp()) + ((size_t)l * SEQ + t0) * 64 + lane;
#pragma unroll
    for (int r = 0; r < 8; ++r) o[r * 64] = f2bf(sinf(fr * a[r]));
  }
  for (int idx = bid * 512 + tid; idx < SEQ * 32; idx += nb * 512) {
    const int pos = idx >> 5, j = idx & 31;
    const float inv = powf(10000.f, -((float)(2 * j) / 64.f));
    const float ang = (float)pos * inv;
    P.ropeCp()[idx] = cosf(ang); P.ropeSp()[idx] = sinf(ang);
  }
}

__device__ __forceinline__ int g_lds_off(int row, int ch) { return row * 128 + ((ch ^ ((row >> 1) & 7)) << 4); }

template <int MODE>
__device__ __forceinline__ void gemm_tile(const Params& P, int layer, int m0, int n0, char* lds, int TIDX, bool preloaded = false, int nm0 = -1, int nn0 = 0) {
  int tid = TIDX; asm volatile("" : "+v"(tid));
  const int wid = tid >> 6, lane = tid & 63, r32 = lane & 31, hi = lane >> 5;
  const int wm = wid >> 2, wn = wid & 3;
  constexpr int K = (MODE == 1) ? DMIX : DM;
  constexpr int NK = K / 64;
  const u16* Bt = (MODE == 0) ? P.WinTp() + (size_t)layer * DIN * DM : (MODE == 1) ? P.WoutTp() + (size_t)layer * DM * DMIX : P.WmTp() + (size_t)layer * DM * DM;
  const int srow = tid >> 3, sch = tid & 7;
  f32x16 acc[4][2];
#pragma unroll
  for (int a = 0; a < 4; ++a)
#pragma unroll
    for (int b = 0; b < 2; ++b) acc[a][b] = f32x16{};
  u32x4 ra[4], rb[4];
  auto a_ptr = [&](int kt, int mm) -> const u16* {
    if (MODE == 0) return P.Hp() + (size_t)mm * DM + kt * 64;
    if (MODE == 2) return P.Mnp() + ((size_t)layer * NB * MEML + mm) * DM + kt * 64;
    const int src = kt >> 3, ko = (kt & 7) * 64;
    const u16* b = (src == 0) ? P.YAp() : (src == 1) ? P.YBp() : P.GAp();
    return b + (size_t)mm * GW + ko;
  };
  constexpr int LDA = (MODE == 1) ? GW : DM;
#define G_LOAD_AT(kt, mm, nn) do { const u16* ap = a_ptr(kt, mm); const u16* bp = Bt + (size_t)(nn) * K + (kt) * 64;                       \
    _Pragma("unroll") for (int i = 0; i < 4; ++i) {                                                                      \
      ra[i] = *reinterpret_cast<const u32x4*>(ap + (size_t)(srow + i * 64) * LDA + sch * 8);                            \
      rb[i] = *reinterpret_cast<const u32x4*>(bp + (size_t)(srow + i * 64) * K + sch * 8); } } while (0)
#define G_WRITE(buf) do { char* la = lds + (buf) * 65536; char* lb = la + 32768;                                          \
    _Pragma("unroll") for (int i = 0; i < 4; ++i) {                                                                      \
      *reinterpret_cast<u32x4*>(la + g_lds_off(srow + i * 64, sch)) = ra[i];                                             \
      *reinterpret_cast<u32x4*>(lb + g_lds_off(srow + i * 64, sch)) = rb[i]; } } while (0)
#define G_LOAD(kt) G_LOAD_AT(kt, m0, n0)
  constexpr int KT0 = 0, KT1 = NK;
  if (!preloaded) { __syncthreads(); G_LOAD(KT0); G_WRITE(KT0 & 1); }
  __syncthreads();
  for (int kt = KT0; kt < KT1; ++kt) {
    if (kt + 1 < KT1) G_LOAD(kt + 1);
    const char* la = lds + (kt & 1) * 65536; const char* lb = la + 32768;
#pragma unroll
    for (int ks = 0; ks < 4; ++ks) {
      bf16x8 af[4], bfr[2];
#pragma unroll
      for (int mb = 0; mb < 4; ++mb) af[mb] = *reinterpret_cast<const bf16x8*>(la + g_lds_off(wm * 128 + mb * 32 + r32, ks * 2 + hi));
#pragma unroll
      for (int nb2 = 0; nb2 < 2; ++nb2) bfr[nb2] = *reinterpret_cast<const bf16x8*>(lb + g_lds_off(wn * 64 + nb2 * 32 + r32, ks * 2 + hi));
#pragma unroll
      for (int mb = 0; mb < 4; ++mb)
#pragma unroll
        for (int nb2 = 0; nb2 < 2; ++nb2) acc[mb][nb2] = __builtin_amdgcn_mfma_f32_32x32x16_bf16(af[mb], bfr[nb2], acc[mb][nb2], 0, 0, 0);
    }
    if (kt + 1 < KT1) G_WRITE((kt + 1) & 1);
    __syncthreads();
  }
  if (nm0 >= 0) G_LOAD_AT(0, nm0, nn0);
  const int rbase = m0 + wm * 128, cbase = n0 + wn * 64;
  if (MODE == 1) {
    const float* xin = (layer == 0) ? P.x : P.out;
#pragma unroll
    for (int mb = 0; mb < 4; ++mb)
#pragma unroll
      for (int r = 0; r < 16; ++r) {
        const size_t row = rbase + mb * 32 + crow(r, hi);
#pragma unroll
        for (int nb2 = 0; nb2 < 2; ++nb2) { const size_t idx = row * DM + cbase + nb2 * 32 + r32; P.out[idx] = xin[idx] + acc[mb][nb2][r]; }
      }
  } else if (MODE == 2) {
    u16* o = P.MemKVp() + (size_t)layer * NB * MEML * DM;
#pragma unroll
    for (int mb = 0; mb < 4; ++mb)
#pragma unroll
      for (int r = 0; r < 16; ++r) {
        const size_t row = rbase + mb * 32 + crow(r, hi);
#pragma unroll
        for (int nb2 = 0; nb2 < 2; ++nb2) o[row * DM + cbase + nb2 * 32 + r32] = f2bf(acc[mb][nb2][r]);
      }
  } else {
    const int region = n0 >> 9;
    const int cl = (cbase & 511);
    if (region <= 1) {
      u16* o = (region == 0) ? P.Qp() : P.Kp();
#pragma unroll
      for (int mb = 0; mb < 4; ++mb)
#pragma unroll
        for (int r = 0; r < 16; ++r) {
          const int row = rbase + mb * 32 + crow(r, hi);
          const int pos = row & (SEQ - 1);
          const float c = P.ropeCp()[pos * 32 + r32], s = P.ropeSp()[pos * 32 + r32];
          const float x1 = acc[mb][0][r], x2 = acc[mb][1][r];
          const float qs = (region == 0) ? 0.125f * 1.4426950408889634f : 1.f;
          o[(size_t)row * GW + cl + r32] = f2bf((x1 * c - x2 * s) * qs);
          o[(size_t)row * GW + cl + 32 + r32] = f2bf((x2 * c + x1 * s) * qs);
        }
    } else if (region >= 4 && region <= 7) {
      const int hc0 = cbase - 2048;
#pragma unroll
      for (int mb = 0; mb < 4; ++mb)
#pragma unroll
        for (int nb2 = 0; nb2 < 2; ++nb2)
#pragma unroll
          for (int g = 0; g < 4; ++g) {
            const int row = rbase + mb * 32 + 8 * g + 4 * hi;
            const int b = row >> 13, s = row & (SEQ - 1);
            u32x2 w = {cvtpk(acc[mb][nb2][4 * g], acc[mb][nb2][4 * g + 1]), cvtpk(acc[mb][nb2][4 * g + 2], acc[mb][nb2][4 * g + 3])};
            *reinterpret_cast<u32x2*>(P.HYTp() + ((size_t)(b * 2048 + hc0 + nb2 * 32 + r32)) * SEQ + s) = w;
          }
    } else {
      u16* o = P.Qp() + (size_t)((region >= 8) ? region - 4 : region) * ((size_t)NTOK * GW);
#pragma unroll
      for (int mb = 0; mb < 4; ++mb)
#pragma unroll
        for (int r = 0; r < 16; ++r) {
          const size_t row = rbase + mb * 32 + crow(r, hi);
#pragma unroll
          for (int nb2 = 0; nb2 < 2; ++nb2) o[row * GW + cl + nb2 * 32 + r32] = f2bf(acc[mb][nb2][r] * ((region == 8) ? 0.088388347648318440f * 1.4426950408889634f : 1.f));
        }
    }
  }
  if (nm0 >= 0) G_WRITE(0);
#undef G_LOAD
#undef G_LOAD_AT
#undef G_WRITE
}

constexpr int KVBLK = 64;
constexpr size_t SHM_V = KVBLK * 128 * 2, SHM_K = KVBLK * 128 * 2;
constexpr float THR = 8.f;
#define KSWZ(row, colB) ((row) * 256 + ((colB) ^ (((row) & 7) << 4)))

template <int SCALE_I>
struct ScaleC {};

constexpr float THRL = 8.f * 1.4426950408889634f;
__device__ __forceinline__ void partialSM_first(f32x16& p0, f32x16& p1, float& m_reg, float& alpha) {
  float pmax = p0[0];
#pragma unroll
  for (int r = 1; r < 16; ++r) pmax = fmaxf(pmax, p0[r]);
#pragma unroll
  for (int r = 0; r < 16; ++r) pmax = fmaxf(pmax, p1[r]);
  { auto rr = __builtin_amdgcn_permlane32_swap(__float_as_uint(pmax), __float_as_uint(pmax), false, false);
    pmax = fmaxf(__uint_as_float(rr[0]), __uint_as_float(rr[1])); }
  m_reg += pmax; alpha = 1.f;
#pragma unroll
  for (int r = 0; r < 16; ++r) p0[r] -= pmax;
#pragma unroll
  for (int r = 0; r < 16; ++r) p1[r] -= pmax;
#pragma unroll
  for (int r = 0; r < 16; ++r) p0[r] = __builtin_amdgcn_exp2f(p0[r]);
}
__device__ __forceinline__ void finishSM(f32x16& p0, f32x16& p1, float alpha, float& l_reg, bf16x8& pa0, bf16x8& pa1, bf16x8& pa2, bf16x8& pa3) {
#pragma unroll
  for (int r = 0; r < 16; ++r) p1[r] = __builtin_amdgcn_exp2f(p1[r]);
  float ps = 0;
#pragma unroll
  for (int r = 0; r < 16; ++r) ps += p0[r];
#pragma unroll
  for (int r = 0; r < 16; ++r) ps += p1[r];
  { auto rr = __builtin_amdgcn_permlane32_swap(__float_as_uint(ps), __float_as_uint(ps), false, false);
    ps = __uint_as_float(rr[0]) + __uint_as_float(rr[1]); }
  l_reg = l_reg * alpha + ps;
#define PK4(P, BASE, OUT) do { unsigned a0 = cvtpk(P[BASE + 0], P[BASE + 1]), a1 = cvtpk(P[BASE + 2], P[BASE + 3]);   \
    unsigned b0 = cvtpk(P[BASE + 4], P[BASE + 5]), b1 = cvtpk(P[BASE + 6], P[BASE + 7]);                              \
    auto r0 = __builtin_amdgcn_permlane32_swap(a0, b0, false, false); auto r1 = __builtin_amdgcn_permlane32_swap(a1, b1, false, false); \
    u32x4 w = {r0[0], r1[0], r0[1], r1[1]}; OUT = *reinterpret_cast<bf16x8*>(&w); } while (0)
  PK4(p0, 0, pa0); PK4(p0, 8, pa1); PK4(p1, 0, pa2); PK4(p1, 8, pa3);
#undef PK4
}
template <int NKS>
__device__ __forceinline__ void qkt(f32x16& p0, f32x16& p1, const char* Ks, const bf16x8* qr, int r32, int hi, int kcolB, float minit) {
#pragma unroll
  for (int r = 0; r < 16; ++r) { p0[r] = minit; p1[r] = minit; }
#pragma unroll
  for (int d0 = 0; d0 < NKS; ++d0) { const int cb = kcolB + (d0 * 16 + hi * 8) * 2;
    bf16x8 b0 = *reinterpret_cast<const bf16x8*>(Ks + KSWZ(r32, cb));
    bf16x8 b1 = *reinterpret_cast<const bf16x8*>(Ks + KSWZ(32 + r32, cb));
    p0 = __builtin_amdgcn_mfma_f32_32x32x16_bf16(b0, qr[d0], p0, 0, 0, 0);
    p1 = __builtin_amdgcn_mfma_f32_32x32x16_bf16(b1, qr[d0], p1, 0, 0, 0); }
}
__device__ __forceinline__ int v_st(int k, int c) { const int kk = (k & ~0xC) | ((k & 4) << 1) | ((k & 8) >> 1); return ((kk >> 3) * 4 + (c >> 5)) * 512 + ((kk & 7) * 32 + (c & 31)) * 2; }
__device__ __forceinline__ int v_rd_base(int lane) { return ((lane & 3) << 3) | (((lane >> 2) & 3) << 6) | (((lane >> 4) & 1) << 5) | (((lane >> 5) & 1) << 8); }
constexpr int v_rd_off(int d0, int ks, int half) { return d0 * 512 + ks * 4096 + half * 2048; }
template <int OFF> __device__ __forceinline__ s16x4 tr_read(int vb) {
  s16x4 r; asm volatile("ds_read_b64_tr_b16 %0, %1 offset:%2" : "=&v"(r) : "v"(vb), "i"(OFF) : "memory"); return r;
}
template <int D0> __device__ __forceinline__ void pv_one(f32x16& od, int vb, bf16x8 pa0, bf16x8 pa1, bf16x8 pa2, bf16x8 pa3) {
  const s16x4 l0 = tr_read<v_rd_off(D0, 0, 0)>(vb), h0 = tr_read<v_rd_off(D0, 0, 1)>(vb), l1 = tr_read<v_rd_off(D0, 1, 0)>(vb), h1 = tr_read<v_rd_off(D0, 1, 1)>(vb);
  const s16x4 l2 = tr_read<v_rd_off(D0, 2, 0)>(vb), h2 = tr_read<v_rd_off(D0, 2, 1)>(vb), l3 = tr_read<v_rd_off(D0, 3, 0)>(vb), h3 = tr_read<v_rd_off(D0, 3, 1)>(vb);
  asm volatile("s_waitcnt lgkmcnt(0)" ::: "memory"); SBAR();
#define PK(L, H) (bf16x8){L[0], L[1], L[2], L[3], H[0], H[1], H[2], H[3]}
  od = __builtin_amdgcn_mfma_f32_32x32x16_bf16(pa0, PK(l0, h0), od, 0, 0, 0);
  od = __builtin_amdgcn_mfma_f32_32x32x16_bf16(pa1, PK(l1, h1), od, 0, 0, 0);
  od = __builtin_amdgcn_mfma_f32_32x32x16_bf16(pa2, PK(l2, h2), od, 0, 0, 0);
  od = __builtin_amdgcn_mfma_f32_32x32x16_bf16(pa3, PK(l3, h3), od, 0, 0, 0);
#undef PK
}
__device__ __forceinline__ void pv_d0(f32x16* o, int vb, bf16x8 pa0, bf16x8 pa1, bf16x8 pa2, bf16x8 pa3) {
  pv_one<0>(o[0], vb, pa0, pa1, pa2, pa3); pv_one<1>(o[1], vb, pa0, pa1, pa2, pa3); pv_one<2>(o[2], vb, pa0, pa1, pa2, pa3); pv_one<3>(o[3], vb, pa0, pa1, pa2, pa3);
}

struct VFrag { s16x4 l0, h0, l1, h1, l2, h2, l3, h3; };
template <int D0> __device__ __forceinline__ void pv_ld(VFrag& f, int vb) {
  f.l0 = tr_read<v_rd_off(D0, 0, 0)>(vb); f.h0 = tr_read<v_rd_off(D0, 0, 1)>(vb); f.l1 = tr_read<v_rd_off(D0, 1, 0)>(vb); f.h1 = tr_read<v_rd_off(D0, 1, 1)>(vb);
  f.l2 = tr_read<v_rd_off(D0, 2, 0)>(vb); f.h2 = tr_read<v_rd_off(D0, 2, 1)>(vb); f.l3 = tr_read<v_rd_off(D0, 3, 0)>(vb); f.h3 = tr_read<v_rd_off(D0, 3, 1)>(vb);
}
__device__ __forceinline__ void pv_mm(f32x16& od, const VFrag& f, bf16x8 pa0, bf16x8 pa1, bf16x8 pa2, bf16x8 pa3) {
#define PK(L, H) (bf16x8){L[0], L[1], L[2], L[3], H[0], H[1], H[2], H[3]}
  od = __builtin_amdgcn_mfma_f32_32x32x16_bf16(pa0, PK(f.l0, f.h0), od, 0, 0, 0);
  od = __builtin_amdgcn_mfma_f32_32x32x16_bf16(pa1, PK(f.l1, f.h1), od, 0, 0, 0);
  od = __builtin_amdgcn_mfma_f32_32x32x16_bf16(pa2, PK(f.l2, f.h2), od, 0, 0, 0);
  od = __builtin_amdgcn_mfma_f32_32x32x16_bf16(pa3, PK(f.l3, f.h3), od, 0, 0, 0);
#undef PK
}
template <bool PIPE>
__device__ __forceinline__ void pv_sm(f32x16* o, int vb, bf16x8 pa0, bf16x8 pa1, bf16x8 pa2, bf16x8 pa3,
                                      f32x16& p0, f32x16& p1, float& m_reg, float& alpha) {
  if constexpr (!PIPE) {
    pv_one<0>(o[0], vb, pa0, pa1, pa2, pa3);
    float pmax = p0[0];
#pragma unroll
    for (int r = 1; r < 16; ++r) pmax = fmaxf(pmax, p0[r]);
    pv_one<1>(o[1], vb, pa0, pa1, pa2, pa3);
#pragma unroll
    for (int r = 0; r < 16; ++r) pmax = fmaxf(pmax, p1[r]);
    { auto rr = __builtin_amdgcn_permlane32_swap(__float_as_uint(pmax), __float_as_uint(pmax), false, false);
      pmax = fmaxf(__uint_as_float(rr[0]), __uint_as_float(rr[1])); }
    pv_one<2>(o[2], vb, pa0, pa1, pa2, pa3);
    if (__builtin_expect(__all(pmax <= THRL), 1)) { alpha = 1.f; }
    else {
      const float dl = fmaxf(pmax, 0.f);
      alpha = __builtin_amdgcn_exp2f(-dl); m_reg += dl;
#pragma unroll
      for (int r = 0; r < 16; ++r) p0[r] -= dl;
#pragma unroll
      for (int r = 0; r < 16; ++r) p1[r] -= dl;
    }
    pv_one<3>(o[3], vb, pa0, pa1, pa2, pa3);
#pragma unroll
    for (int r = 0; r < 16; ++r) p0[r] = __builtin_amdgcn_exp2f(p0[r]);
    return;
  }
  struct HF { s16x4 l0, h0, l1, h1; } f0, f1, f2;
#define LDH(F, D0, H) do { F.l0 = tr_read<v_rd_off(D0, 2 * (H), 0)>(vb); F.h0 = tr_read<v_rd_off(D0, 2 * (H), 1)>(vb); \
                           F.l1 = tr_read<v_rd_off(D0, 2 * (H) + 1, 0)>(vb); F.h1 = tr_read<v_rd_off(D0, 2 * (H) + 1, 1)>(vb); } while (0)
#define PKH(L, H) (bf16x8){L[0], L[1], L[2], L[3], H[0], H[1], H[2], H[3]}
#define MMH(OD, F, PX, PY) do { OD = __builtin_amdgcn_mfma_f32_32x32x16_bf16(PX, PKH(F.l0, F.h0), OD, 0, 0, 0); \
                                OD = __builtin_amdgcn_mfma_f32_32x32x16_bf16(PY, PKH(F.l1, F.h1), OD, 0, 0, 0); } while (0)
#define WAITL(n) do { asm volatile("s_waitcnt lgkmcnt(" #n ")" ::: "memory"); SBAR(); } while (0)
  LDH(f0, 0, 0); LDH(f1, 0, 1); LDH(f2, 1, 0);
  WAITL(8); MMH(o[0], f0, pa0, pa1); SBAR(); LDH(f0, 1, 1);
  WAITL(8); MMH(o[0], f1, pa2, pa3);
  float pmax = p0[0];
#pragma unroll
  for (int r = 1; r < 16; ++r) pmax = fmaxf(pmax, p0[r]);
  SBAR(); LDH(f1, 2, 0);
  WAITL(8); MMH(o[1], f2, pa0, pa1); SBAR(); LDH(f2, 2, 1);
  WAITL(8); MMH(o[1], f0, pa2, pa3);
#pragma unroll
  for (int r = 0; r < 16; ++r) pmax = fmaxf(pmax, p1[r]);
  { auto rr = __builtin_amdgcn_permlane32_swap(__float_as_uint(pmax), __float_as_uint(pmax), false, false);
    pmax = fmaxf(__uint_as_float(rr[0]), __uint_as_float(rr[1])); }
  SBAR(); LDH(f0, 3, 0);
  WAITL(8); MMH(o[2], f1, pa0, pa1); SBAR(); LDH(f1, 3, 1);
  WAITL(8); MMH(o[2], f2, pa2, pa3);
  if (__builtin_expect(__all(pmax <= THRL), 1)) { alpha = 1.f; }
  else {
    const float dl = fmaxf(pmax, 0.f);
    alpha = __builtin_amdgcn_exp2f(-dl); m_reg += dl;
#pragma unroll
    for (int r = 0; r < 16; ++r) p0[r] -= dl;
#pragma unroll
    for (int r = 0; r < 16; ++r) p1[r] -= dl;
  }
  WAITL(4); MMH(o[3], f0, pa0, pa1);
  WAITL(0); MMH(o[3], f1, pa2, pa3);
#pragma unroll
  for (int r = 0; r < 16; ++r) p0[r] = __builtin_amdgcn_exp2f(p0[r]);
#undef LDH
#undef PKH
#undef MMH
#undef WAITL
}

template <bool DIFF>
__device__ __forceinline__ void attn_item(const Params& P, int layer, const u16* __restrict__ Qlane, const u16* __restrict__ Kh, const u16* __restrict__ Vh,
                                          int seq, int tok0, int hcol, float lam, float post, char* lds, int TIDX) {
  constexpr int NKS = DIFF ? 4 : 8;
  constexpr int LDK = DIFF ? GW : DM;
  int tid = TIDX; asm volatile("" : "+v"(tid));
  const int wid = tid >> 6, lane = tid & 63, r32 = lane & 31, hi = lane >> 5;
  const int mp = DIFF ? (wid >> 2) : 0;
  char* V_lds = lds; char* K_lds = lds + 3 * SHM_V;
  float* ws = (float*)(lds + 3 * SHM_V + 3 * SHM_K) + wid * 64; float* li_l = ws; float* al_l = ws + 32;
  float m_reg = 0.f, l_reg = 0; f32x16 o[4];
#pragma unroll
  for (int d = 0; d < 4; ++d) o[d] = f32x16{};
  bf16x8 qr[NKS];
#pragma unroll
  for (int d0 = 0; d0 < NKS; ++d0) qr[d0] = *reinterpret_cast<const bf16x8*>(Qlane + d0 * 16);
  const int kcolB = mp * 128;
  const int sr = tid >> 4, sc = (tid & 15) * 8, vst0 = v_st(sr, sc), vst1 = v_st(32 + sr, sc);
  const int vb0 = (int)(uintptr_t)V_lds + v_rd_base(lane);
  constexpr int SD = DIFF ? 2 : 1;
  struct { bf16x8 vs0, vs1, ks0, ks1; } sr_[SD];
#define SLOAD(i, k0) do { sr_[i].vs0 = *reinterpret_cast<const bf16x8*>(&Vh[(long)((k0) + sr) * LDK + sc]); sr_[i].vs1 = *reinterpret_cast<const bf16x8*>(&Vh[(long)((k0) + 32 + sr) * LDK + sc]); \
    sr_[i].ks0 = *reinterpret_cast<const bf16x8*>(&Kh[(long)((k0) + sr) * LDK + sc]); sr_[i].ks1 = *reinterpret_cast<const bf16x8*>(&Kh[(long)((k0) + 32 + sr) * LDK + sc]); } while (0)
#define SWRITE(b, i) do { *(bf16x8*)(V_lds + (b) * SHM_V + vst0) = sr_[i].vs0;          \
    *(bf16x8*)(V_lds + (b) * SHM_V + vst1) = sr_[i].vs1; int kc = sc * 2;               \
    *(bf16x8*)(K_lds + (b) * SHM_K + KSWZ(sr, kc)) = sr_[i].ks0;                       \
    *(bf16x8*)(K_lds + (b) * SHM_K + KSWZ(32 + sr, kc)) = sr_[i].ks1; } while (0)
#define SWAIT() do { if constexpr (SD == 2) asm volatile("s_waitcnt vmcnt(4)" ::: "memory"); else asm volatile("s_waitcnt vmcnt(0)" ::: "memory"); } while (0)
#define RESC(a) do { if (__any((a) < 1.f)) { if (hi == 0) al_l[r32] = (a); asm volatile("s_waitcnt lgkmcnt(0)" ::: "memory"); \
    _Pragma("unroll") for (int d = 0; d < 4; ++d) _Pragma("unroll") for (int r = 0; r < 16; ++r) o[d][r] *= al_l[crow(r, hi)]; } } while (0)
  f32x16 pA0, pA1, pB0, pB1; float alA, alB; bf16x8 pa0, pa1, pa2, pa3; const int NT = seq / KVBLK;
  constexpr int SE = 0, SO = SD - 1;
  __syncthreads();
  SLOAD(SE, 0); asm volatile("s_waitcnt vmcnt(0)" ::: "memory"); SWRITE(0, SE); __syncthreads();
  qkt<NKS>(pA0, pA1, K_lds, qr, r32, hi, kcolB, 0.f); partialSM_first(pA0, pA1, m_reg, alA);
  SLOAD(SO, KVBLK); if constexpr (SD == 2) { if (2 < NT) SLOAD(SE, 2 * KVBLK); }
  SWAIT(); SWRITE(1, SO); __syncthreads();
  int bp = 0, bc = 1;
  for (int j = 1; j + 1 < NT; j += 2) {
    int bn = (bc == 2) ? 0 : bc + 1;
    SBAR(); qkt<NKS>(pB0, pB1, K_lds + bc * (int)SHM_K, qr, r32, hi, kcolB, -m_reg);
    finishSM(pA0, pA1, alA, l_reg, pa0, pa1, pa2, pa3); SBAR();
    SLOAD(SO, (j + SD) * KVBLK); SBAR();
    pv_sm<DIFF>(o, vb0 + bp * (int)SHM_V, pa0, pa1, pa2, pa3, pB0, pB1, m_reg, alB);
    SWAIT(); SWRITE(bn, SE);
    RESC(alB); __syncthreads();
    bp = bc; bc = bn; bn = (bc == 2) ? 0 : bc + 1;
    SBAR(); qkt<NKS>(pA0, pA1, K_lds + bc * (int)SHM_K, qr, r32, hi, kcolB, -m_reg);
    finishSM(pB0, pB1, alB, l_reg, pa0, pa1, pa2, pa3); SBAR();
    if (SD == 1 || j + 3 < NT) SLOAD(SE, (j + 1 + SD) * KVBLK); SBAR();
    pv_sm<DIFF>(o, vb0 + bp * (int)SHM_V, pa0, pa1, pa2, pa3, pA0, pA1, m_reg, alA);
    SWAIT(); SWRITE(bn, SO);
    RESC(alA); __syncthreads();
    bp = bc; bc = bn;
  }
  SBAR(); qkt<NKS>(pB0, pB1, K_lds + bc * (int)SHM_K, qr, r32, hi, kcolB, -m_reg);
  finishSM(pA0, pA1, alA, l_reg, pa0, pa1, pa2, pa3); SBAR();
  pv_sm<DIFF>(o, vb0 + bp * (int)SHM_V, pa0, pa1, pa2, pa3, pB0, pB1, m_reg, alB);
  RESC(alB);
  finishSM(pB0, pB1, alB, l_reg, pa0, pa1, pa2, pa3); SBAR();
  pv_d0(o, vb0 + bc * (int)SHM_V, pa0, pa1, pa2, pa3);
  if (hi == 0) li_l[r32] = l_reg; asm volatile("s_waitcnt lgkmcnt(0)" ::: "memory");
  float rli[16];
#pragma unroll
  for (int r = 0; r < 16; ++r) rli[r] = __builtin_amdgcn_rcpf(li_l[crow(r, hi)]);
  if (DIFF) {
    const int qw = wid & 3;
    float* X = (float*)lds;
    __syncthreads();
    if (mp == 1) {
#pragma unroll
      for (int r = 0; r < 16; ++r)
#pragma unroll
        for (int d0 = 0; d0 < 4; ++d0) X[(qw * 32 + crow(r, hi)) * 128 + d0 * 32 + r32] = o[d0][r] * rli[r];
    }
    __syncthreads();
    if (mp == 0) {
      float ss[16];
#pragma unroll
      for (int r = 0; r < 16; ++r) {
        float s2 = 0;
#pragma unroll
        for (int d0 = 0; d0 < 4; ++d0) { const float v = o[d0][r] * rli[r] - lam * X[(qw * 32 + crow(r, hi)) * 128 + d0 * 32 + r32]; o[d0][r] = v; s2 += v * v; }
        ss[r] = s2;
      }
#pragma unroll
      for (int r = 0; r < 16; ++r) {
#pragma unroll
        for (int m = 16; m >= 1; m >>= 1) ss[r] += __shfl_xor(ss[r], m);
      }
      float gs[4];
#pragma unroll
      for (int d0 = 0; d0 < 4; ++d0) gs[d0] = P.g_sub[layer * 128 + d0 * 32 + r32] * post;
#pragma unroll
      for (int r = 0; r < 16; ++r) {
        const float rs = rsqrtf(ss[r] * (1.f / 128.f) + EPS);
        const size_t tok = tok0 + crow(r, hi);
#pragma unroll
        for (int d0 = 0; d0 < 4; ++d0) {
          const size_t idx = tok * GW + hcol + d0 * 32 + r32;
          const float g = bf2f(P.GAp()[idx]);
          P.YAp()[idx] = f2bf(o[d0][r] * rs * gs[d0] * silu(g));
        }
      }
    }
    __syncthreads();
  } else {
#pragma unroll
    for (int r = 0; r < 16; ++r) {
      const size_t tok = tok0 + crow(r, hi);
#pragma unroll
      for (int d0 = 0; d0 < 4; ++d0) {
        const size_t idx = tok * GW + hcol + d0 * 32 + r32;
        const float g = bf2f(P.MGp()[idx]);
        P.GAp()[idx] = f2bf(o[d0][r] * rli[r] * silu(g));
      }
    }
    __syncthreads();
  }
#undef SLOAD
#undef SWRITE
#undef SWAIT
#undef RESC
}

__device__ __forceinline__ void phase_attn(const Params& P, int layer, char* lds, int TIDX, int BIDX) {
  const int wid = TIDX >> 6, lane = TIDX & 63, r32 = lane & 31, hi = lane >> 5;
  float d1 = P.lq1[layer * 64 + lane] * P.lk1[layer * 64 + lane], d2 = P.lq2[layer * 64 + lane] * P.lk2[layer * 64 + lane];
  d1 = wave_sum(d1); d2 = wave_sum(d2);
  const float lam_init = 0.8f - 0.6f * expf(-0.3f * (float)layer);
  const float lam = expf(d1) - expf(d2) + lam_init;
  const float post = 1.f - lam_init;
  const int nb = gridDim.x;
#pragma unroll 1
  for (int rep = 0; rep < REP_ATT; ++rep)
  for (int it = BIDX; it < 512; it += nb) {
    const int bh = it & 7, qb = it >> 3, b = bh >> 2, h = bh & 3;
    const int mp = wid >> 2, qw = wid & 3;
    const int tok0 = b * SEQ + qb * 128 + qw * 32;
    const u16* Qlane = P.Qp() + (size_t)(tok0 + r32) * GW + h * 128 + mp * 64 + hi * 8;
    const u16* Kh = P.Kp() + (size_t)(b * SEQ) * GW + h * 128;
    const u16* Vh = P.Vp() + (size_t)(b * SEQ) * GW + h * 128;
    attn_item<true>(P, layer, Qlane, Kh, Vh, SEQ, tok0, h * 128, lam, post, lds, TIDX);
  }
  if (layer == 0) {
    for (int it = BIDX; it < 16; it += nb) { const int r = it & 7; if (it < 8) gemm_tile<2>(P, 0, (r >> 2) * 256, (r & 3) * 256, lds, TIDX); else gemm_tile<2>(P, 1, (r >> 2) * 256, (r & 3) * 256, lds, TIDX); }
  }
}

__device__ __forceinline__ constexpr float CW(int k) {
  switch (k & 31) {
    case 0: return 1.f; case 1: return 0.98078528040323043f; case 2: return 0.92387953251128674f; case 3: return 0.83146961230254524f;
    case 4: return 0.70710678118654752f; case 5: return 0.55557023301960218f; case 6: return 0.38268343236508978f; case 7: return 0.19509032201612825f;
    case 8: return 0.f; case 9: return -0.19509032201612825f; case 10: return -0.38268343236508978f; case 11: return -0.55557023301960218f;
    case 12: return -0.70710678118654752f; case 13: return -0.83146961230254524f; case 14: return -0.92387953251128674f; case 15: return -0.98078528040323043f;
    default: return -1.f; }
}
__device__ __forceinline__ constexpr float SWc(int k) {
  switch (k & 31) {
    case 0: return 0.f; case 1: return 0.19509032201612825f; case 2: return 0.38268343236508978f; case 3: return 0.55557023301960218f;
    case 4: return 0.70710678118654752f; case 5: return 0.83146961230254524f; case 6: return 0.92387953251128674f; case 7: return 0.98078528040323043f;
    case 8: return 1.f; case 9: return 0.98078528040323043f; case 10: return 0.92387953251128674f; case 11: return 0.83146961230254524f;
    case 12: return 0.70710678118654752f; case 13: return 0.55557023301960218f; case 14: return 0.38268343236508978f; case 15: return 0.19509032201612825f;
    default: return 0.f; }
}
__device__ __forceinline__ constexpr int brev5(int p) { return ((p & 1) << 4) | ((p & 2) << 2) | (p & 4) | ((p & 8) >> 2) | ((p & 16) >> 4); }
__device__ __forceinline__ int fsw(int a) { return a ^ (((a >> 5) & 15) | (((a >> 9) & 1) << 4)); }

using f2 = __attribute__((ext_vector_type(2))) float;
__device__ __forceinline__ f2 cmul_neg(f2 d, float c, float s) { return d * c + f2{d[1], -d[0]} * s; }
__device__ __forceinline__ f2 cmul_pos(f2 d, float c, float s) { return d * c + f2{-d[1], d[0]} * s; }
template <int R, bool INV, int OFF>
__device__ __forceinline__ void fft_net(f2 (&x)[32]) {
  constexpr int LOGR = (R == 32) ? 5 : 4;
  if (!INV) {
#pragma unroll
    for (int lg = LOGR - 1; lg >= 0; --lg) {
      const int h = 1 << lg;
#pragma unroll
      for (int i = 0; i < R; ++i) {
        if (i & h) continue;
        const int k = (i & (h - 1)) * (16 / h);
        const f2 a = x[OFF + i], b = x[OFF + i + h];
        x[OFF + i] = a + b;
        const f2 d = a - b;
        if (k == 0) x[OFF + i + h] = d;
        else if (k == 8) x[OFF + i + h] = f2{d[1], -d[0]};
        else x[OFF + i + h] = cmul_neg(d, CW(k), SWc(k));
      }
    }
  } else {
#pragma unroll
    for (int lg = 0; lg < LOGR; ++lg) {
      const int h = 1 << lg;
#pragma unroll
      for (int i = 0; i < R; ++i) {
        if (i & h) continue;
        const int k = (i & (h - 1)) * (16 / h);
        const f2 a = x[OFF + i], B = x[OFF + i + h];
        f2 b;
        if (k == 0) b = B;
        else if (k == 8) b = f2{-B[1], B[0]};
        else b = cmul_pos(B, CW(k), SWc(k));
        x[OFF + i] = a + b; x[OFF + i + h] = a - b;
      }
    }
  }
}
template <bool INV, int LOGN>
__device__ __forceinline__ void twiddle32(f2 (&x)[32], int j) {
  asm volatile("" : "+v"(j));
  const float turns = (float)j * (1.f / (float)(1 << LOGN));
  const float c1 = __builtin_amdgcn_cosf(turns), s1 = __builtin_amdgcn_sinf(turns);
  const f2 w2 = {c1 * c1 - s1 * s1, 2.f * c1 * s1};
  f2 we = {1.f, 0.f}, wo = {c1, s1};
#pragma unroll
  for (int r = 1; r < 32; ++r) {
    f2 w;
    if (r & 1) { w = wo; wo = cmul_pos(wo, w2[0], w2[1]); }
    else { we = cmul_pos(we, w2[0], w2[1]); w = we; }
    const int p = brev5(r);
    x[p] = INV ? cmul_pos(x[p], w[0], w[1]) : cmul_neg(x[p], w[0], w[1]);
  }
}
__device__ __forceinline__ void fft_fwd_p0(f2 (&x)[32], f2* D, int t) {
  asm volatile("" : "+v"(t));
  fft_net<32, false, 0>(x);
  twiddle32<false, 14>(x, t);
  const int e0 = t ^ ((t >> 5) & 15), e1 = e0 ^ 16;
#pragma unroll
  for (int p = 0; p < 32; ++p) D[p * 512 + ((p & 1) ? e1 : e0)] = x[p];
}
__device__ __forceinline__ void fft_fwd_p1(f2 (&x)[32], f2* D, int t) {
  asm volatile("" : "+v"(t));
  const int j = t & 15, blk = t >> 4, b0 = blk * 512 + ((blk & 1) << 4), b1 = b0 ^ 16;
#pragma unroll
  for (int q = 0; q < 32; ++q) x[q] = D[((q & 1) ? b1 : b0) + (q >> 1) * 32 + (j ^ (q >> 1))];
  fft_net<32, false, 0>(x);
  twiddle32<false, 9>(x, j);
#pragma unroll
  for (int p = 0; p < 32; ++p) D[((p & 1) ? b1 : b0) + (p >> 1) * 32 + (j ^ (p >> 1))] = x[p];
}
__device__ __forceinline__ void fft_p2_load(f2 (&x)[32], f2* D, int t) {
  asm volatile("" : "+v"(t));
#pragma unroll
  for (int u = 0; u < 2; ++u) {
    const int B = u * 512 + t, hb = (B * 16) ^ (((B >> 5) & 1) << 4), m4 = (B >> 1) & 15;
#pragma unroll
    for (int q = 0; q < 16; ++q) x[u * 16 + q] = D[hb + (q ^ m4)];
  }
  fft_net<16, false, 0>(x); fft_net<16, false, 16>(x);
}
__device__ __forceinline__ void fft_p2_inv_store(f2 (&x)[32], f2* D, int t) {
  asm volatile("" : "+v"(t));
  fft_net<16, true, 0>(x); fft_net<16, true, 16>(x);
#pragma unroll
  for (int u = 0; u < 2; ++u) {
    const int B = u * 512 + t, hb = (B * 16) ^ (((B >> 5) & 1) << 4), m4 = (B >> 1) & 15;
#pragma unroll
    for (int q = 0; q < 16; ++q) D[hb + (q ^ m4)] = x[u * 16 + q];
  }
}
__device__ __forceinline__ void fft_inv_p1(f2 (&x)[32], f2* D, int t) {
  asm volatile("" : "+v"(t));
  const int j = t & 15, blk = t >> 4, b0 = blk * 512 + ((blk & 1) << 4), b1 = b0 ^ 16;
#pragma unroll
  for (int q = 0; q < 32; ++q) x[q] = D[((q & 1) ? b1 : b0) + (q >> 1) * 32 + (j ^ (q >> 1))];
  twiddle32<true, 9>(x, j);
  fft_net<32, true, 0>(x);
#pragma unroll
  for (int p = 0; p < 32; ++p) D[((p & 1) ? b1 : b0) + (p >> 1) * 32 + (j ^ (p >> 1))] = x[p];
}
__device__ __forceinline__ void fft_inv_p0(f2 (&x)[32], f2* D, int t) {
  asm volatile("" : "+v"(t));
  const int e0 = t ^ ((t >> 5) & 15), e1 = e0 ^ 16;
#pragma unroll
  for (int q = 0; q < 32; ++q) x[q] = D[q * 512 + ((q & 1) ? e1 : e0)];
  twiddle32<true, 14>(x, t);
  fft_net<32, true, 0>(x);
}

__device__ __forceinline__ float sc_val(const u16* __restrict__ hy, int s, float w0, float w1, float w2, float bias) {
  const int sl = s > 0 ? s - 1 : 0, sr2 = s < SEQ - 1 ? s + 1 : SEQ - 1;
  const float c = bf2f(hy[s]);
  const float l = bf2f(hy[sl]) * (s > 0 ? 1.f : 0.f);
  const float r = bf2f(hy[sr2]) * (s < SEQ - 1 ? 1.f : 0.f);
  return w0 * l + w1 * c + w2 * r + bias;
}

__device__ __forceinline__ void hyena_channel(const Params& P, int layer, int c, char* lds, int TIDX, int BIDX) {
  f2* D = (f2*)lds; float* kcl = (float*)lds; float* wl = (float*)(lds + 131072);
  int t = TIDX; asm volatile("" : "+v"(t));
  const float* cw = P.conv_w + (size_t)layer * 3 * 1536; const float* cb = P.conv_b + (size_t)layer * 1536;
  const u16* hy0 = P.HYTp(); const u16* hy1 = P.HYTp() + (size_t)2048 * SEQ;
  const float min_decay = -3.0701134573253944f, max_decay = -15.350567286626972f;
  const float dF = fabsf(min_decay + (max_decay - min_decay) * ((float)c / 511.f));
  const float dB = fabsf(min_decay + (max_decay - min_decay) * ((float)(511 - c) / 511.f));
  typedef _Float16 h2_t __attribute__((ext_vector_type(2)));
  h2_t* KFH = reinterpret_cast<h2_t*>(P.Kp()) + (size_t)BIDX * 32768 + t * 32;
  {
    float* kcl1 = (float*)(lds + 65536);
    __syncthreads();
    {
      int tf = t; asm volatile("" : "+v"(tf));
      const int lane = tf & 63, r32 = lane & 31, hi = lane >> 5, wv = tf >> 6;
      bf16x8 af[4];
#pragma unroll
      for (int ks = 0; ks < 4; ++ks) {
        float wv8[8];
#pragma unroll
        for (int i = 0; i < 8; ++i) {
          const int rr = r32 & 3;
          const float x = P.hf_w4[((size_t)layer * 64 + ks * 16 + hi * 8 + i) * 2048 + (rr >> 1) * 1024 + (rr & 1) * 512 + c];
          wv8[i] = (r32 < 4) ? x : 0.f;
        }
        u32x4 w = {cvtpk(wv8[0], wv8[1]), cvtpk(wv8[2], wv8[3]), cvtpk(wv8[4], wv8[5]), cvtpk(wv8[6], wv8[7])};
        af[ks] = *reinterpret_cast<bf16x8*>(&w);
      }
      const u16* hb = reinterpret_cast<const u16*>(P.hdnp()) + ((size_t)layer * SEQ + wv * 1024 + r32) * 64 + hi * 8;
#pragma unroll 1
      for (int g = 0; g < 4; ++g) {
        bf16x8 bfr[8][4];
#pragma unroll
        for (int pb = 0; pb < 8; ++pb)
#pragma unroll
          for (int ks = 0; ks < 4; ++ks) bfr[pb][ks] = *reinterpret_cast<const bf16x8*>(hb + (size_t)((g * 8 + pb) * 32) * 64 + ks * 16);
#pragma unroll
        for (int pb = 0; pb < 8; ++pb) {
          f32x16 acc = f32x16{};
#pragma unroll
          for (int ks = 0; ks < 4; ++ks) acc = __builtin_amdgcn_mfma_f32_32x32x16_bf16(af[ks], bfr[pb][ks], acc, 0, 0, 0);
          if (hi == 0) {
            const int tt = wv * 1024 + (g * 8 + pb) * 32 + r32; const float tl = (float)tt * (1.f / 8191.f);
            const float ef = __expf(-tl * dF), eb = (tt == SEQ - 1) ? 0.f : __expf(-tl * dB);
            kcl[tt] = acc[0] * ef; kcl[16383 - tt] = acc[1] * eb;
            kcl1[tt] = acc[2] * ef; kcl1[16383 - tt] = acc[3] * eb;
          }
        }
      }
    }
    __syncthreads();
    f2 x[32];
#pragma unroll
    for (int q = 0; q < 32; ++q) x[q] = f2{kcl[q * 512 + t], kcl1[q * 512 + t]};
    __syncthreads();
    fft_fwd_p0(x, D, t); __syncthreads();
    fft_fwd_p1(x, D, t); __syncthreads();
    fft_p2_load(x, D, t);
    {
      int tx = t; asm volatile("" : "+v"(tx));
#pragma unroll
      for (int u = 0; u < 2; ++u) {
        const int B = u * 512 + tx, hb = (B * 16) ^ (((B >> 5) & 1) << 4), m4 = (B >> 1) & 15;
#pragma unroll
        for (int q = 0; q < 16; ++q) D[hb + (q ^ m4)] = x[u * 16 + q];
      }
      __syncthreads();
#pragma unroll
      for (int u = 0; u < 2; ++u)
#pragma unroll
        for (int q = 0; q < 16; ++q) {
          const unsigned a = (unsigned)((u * 512 + tx) * 16 + q);
          const unsigned kfreq = __builtin_bitreverse32(a) >> 18;
          const unsigned ap = __builtin_bitreverse32((16384u - kfreq) & 16383u) >> 18;
          const f2 v = D[fsw((int)ap)];
          const float wr = x[u * 16 + q][0], wi = x[u * 16 + q][1];
          h2_t k0 = {(_Float16)(0.5f * (wr + v[0])), (_Float16)(0.5f * (wi - v[1]))};
          h2_t k1 = {(_Float16)(0.5f * (wi + v[1])), (_Float16)(0.5f * (v[0] - wr))};
          KFH[u * 16 + q] = k0; KFH[16384 + u * 16 + q] = k1;
        }
    }
  }
  float zr[16], zi[16];
  {
    const float w0 = cw[c], w1 = cw[1536 + c], w2 = cw[3072 + c], bb = cb[c];
#pragma unroll
    for (int q = 0; q < 16; ++q) { const int s = q * 512 + t; zr[q] = sc_val(hy0 + (size_t)c * SEQ, s, w0, w1, w2, bb); zi[q] = sc_val(hy1 + (size_t)c * SEQ, s, w0, w1, w2, bb); if ((q & 3) == 3) SBAR(); }
  }
#pragma unroll 1
  for (int order = 0; order < 2; ++order) {
    const h2_t* KF = KFH + order * 16384;
    f2 x[32];
#pragma unroll
    for (int q = 0; q < 16; ++q) { x[q] = f2{zr[q], zi[q]}; x[q + 16] = f2{0.f, 0.f}; }
    __syncthreads();
    fft_fwd_p0(x, D, t); __syncthreads();
    fft_fwd_p1(x, D, t); __syncthreads();
    fft_p2_load(x, D, t);
#pragma unroll
    for (int q = 0; q < 32; ++q) { const h2_t kh = KF[q]; const float k0 = (float)kh[0] * (1.f / 16384.f), k1 = (float)kh[1] * (1.f / 16384.f); x[q] = cmul_pos(x[q], k0, k1); }
    fft_p2_inv_store(x, D, t); __syncthreads();
    fft_inv_p1(x, D, t); __syncthreads();
    fft_inv_p0(x, D, t);
    int te = t; asm volatile("" : "+v"(te));
    const float skip = P.hy_skip[((size_t)layer * 2 + order) * 512 + c];
    const int xc = (order == 0 ? 512 : 1024) + c;
    const float w0 = cw[xc], w1 = cw[1536 + xc], w2 = cw[3072 + xc], bb = cb[xc];
    if (order == 0) {
#pragma unroll
      for (int q = 0; q < 16; ++q) {
        const int s = q * 512 + te;
        const float x0 = sc_val(hy0 + (size_t)xc * SEQ, s, w0, w1, w2, bb), x1 = sc_val(hy1 + (size_t)xc * SEQ, s, w0, w1, w2, bb);
        zr[q] = x0 * (x[q][0] + skip * zr[q]); zi[q] = x1 * (x[q][1] + skip * zi[q]);
        if ((q & 3) == 3) SBAR();
      }
    } else {
#pragma unroll
      for (int q = 0; q < 16; ++q) {
        const int s = q * 512 + te;
        const float x0 = sc_val(hy0 + (size_t)xc * SEQ, s, w0, w1, w2, bb), x1 = sc_val(hy1 + (size_t)xc * SEQ, s, w0, w1, w2, bb);
        const float g0 = bf2f(hy0[(size_t)(1536 + c) * SEQ + s]), g1 = bf2f(hy1[(size_t)(1536 + c) * SEQ + s]);
        P.YBp()[(size_t)s * GW + c] = f2bf(x0 * (x[q][0] + skip * zr[q]) * silu(g0));
        P.YBp()[(size_t)(SEQ + s) * GW + c] = f2bf(x1 * (x[q][1] + skip * zi[q]) * silu(g1));
        if ((q & 3) == 3) SBAR();
      }
    }
  }
}

__device__ __forceinline__ void phase_hyena_cross(const Params& P, int layer, char* lds, int TIDX, int BIDX) {
  const int nb = gridDim.x;
#pragma unroll 1
  for (int rep = 0; rep < REP_HY; ++rep)
  for (int ci = BIDX; ci < GW; ci += nb) {
    const int c = (nb == 256) ? 64 * (BIDX & 7) + 2 * (BIDX >> 3) + (ci >> 8) : ci;
    hyena_channel(P, layer, c, lds, TIDX, BIDX);
  }
  __syncthreads();
  const int wid = TIDX >> 6, lane = TIDX & 63, r32 = lane & 31, hi = lane >> 5;
#pragma unroll 1
  for (int rep = 0; rep < REP_CROSS; ++rep)
  for (int it = BIDX; it < 256; it += nb) {
    const int h = it & 3, blk = it >> 2;
    const int tok0 = blk * 256 + wid * 32, b = tok0 >> 13;
    const u16* Qlane = P.MQp() + (size_t)(tok0 + r32) * GW + h * 128 + hi * 8;
    const u16* Kh = P.MemKVp() + ((size_t)layer * NB * MEML + b * MEML) * DM + h * 128;
    attn_item<false>(P, layer, Qlane, Kh, Kh + GW, MEML, tok0, h * 128, 0.f, 1.f, lds, TIDX);
  }
}

template <int PH>
__device__ __forceinline__ void run_phase(const Params& P, char* lds, int wave_s) {
  int TIDX = (wave_s << 6) | (int)__builtin_amdgcn_mbcnt_hi(~0u, __builtin_amdgcn_mbcnt_lo(~0u, 0u)); asm volatile("" : "+v"(TIDX));
  int BIDX = blockIdx.x; asm volatile("" : "+s"(BIDX));
  const int nb = gridDim.x, bid = BIDX;
  if constexpr (PH == 0) {
#pragma unroll 1
    for (int rep = 0; rep < REP_PREP; ++rep) phase_prep(P, lds, TIDX, BIDX); }
  else {
    constexpr int layer = (PH - 1) / 5, sub = (PH - 1) % 5;
    if constexpr (sub == 0) {
#pragma unroll 1
      for (int rep = 0; rep < REP_PROJ; ++rep)
      { bool pre = false;
        for (int it = bid; it < 64 * 20; it += nb) { const int tn = it >> 6, tm = it & 63; const int nx = it + nb; const bool hn = nx < 64 * 20;
          gemm_tile<0>(P, layer, tm * 256, tn * 256, lds, TIDX, pre, hn ? (nx & 63) * 256 : -1, hn ? (nx >> 6) * 256 : 0); pre = hn; } }
    } else if constexpr (sub == 1) {
      phase_attn(P, layer, lds, TIDX, BIDX);
    } else if constexpr (sub == 2) {
      phase_hyena_cross(P, layer, lds, TIDX, BIDX);
    } else if constexpr (sub == 3) {
#pragma unroll 1
      for (int rep = 0; rep < (layer == 0 ? REP_OUT0 : 1); ++rep)
      for (int it = bid; it < 64 * 4; it += nb) { const int tn = it >> 6, tm = it & 63; gemm_tile<1>(P, layer, tm * 256, tn * 256, lds, TIDX); }
    } else {
      const int wid = TIDX >> 6, lane = TIDX & 63;
      if constexpr (layer == 0) {
#pragma unroll 1
        for (int rep = 0; rep < REP_NORM0; ++rep)
        for (int it = bid; it < NTOK / 8; it += nb) { const int row = it * 8 + wid; norm_row_bf16(P.out + (size_t)row * DM, P.g_norm + DM, P.Hp() + (size_t)row * DM, lane); }
      } else {
        for (int it = bid; it < NTOK / 8; it += nb) { const int row = it * 8 + wid; norm_row_f32(P.out + (size_t)row * DM, P.g_final, lane); }
      }
    }
  }
}

#define XB_TMO      128
#define XB_XCNT(j)  (256  + 64 * (j))
#define XB_XSUB(j)  (1280 + 64 * (j))
#define XB_XGEN(j)  (2304 + 64 * (j))
#define XB_TOP      3328
#define XB_TOPGEN   3392
#define XCD_BAR_WORDS 3456
#define XB_SPIN_CAP (1u << 18)
#define LAS __attribute__((address_space(3)))

__device__ __forceinline__ unsigned xb_ld(unsigned* p)              { return __hip_atomic_load(p, __ATOMIC_RELAXED, __HIP_MEMORY_SCOPE_AGENT); }
__device__ __forceinline__ unsigned xb_add(unsigned* p, unsigned v) { return __hip_atomic_fetch_add(p, v, __ATOMIC_RELAXED, __HIP_MEMORY_SCOPE_AGENT); }
__device__ __forceinline__ unsigned xb_xcc_id() { return (unsigned)__builtin_amdgcn_s_getreg((3 << 11) | 20) & 0xFu; }
#define XB_SPIN(cond, bar) do { unsigned _sp = 0; while (cond) { __builtin_amdgcn_s_sleep(1); \
    if ((++_sp & 255u) == 0u) { if (xb_ld(&(bar)[XB_TMO])) break; if (_sp > XB_SPIN_CAP) { atomicAdd(&(bar)[XB_TMO], 1u); break; } } } } while (0)

struct XcdBarrier {
    unsigned* bar; unsigned x;
    volatile LAS unsigned* st;
};

__device__ __forceinline__ XcdBarrier xcd_barrier_post(unsigned* bar, volatile LAS unsigned* st) {
    XcdBarrier b; b.bar = bar; b.x = xb_xcc_id(); b.st = st;
    if (threadIdx.x == 0) (void)xb_add(&bar[XB_XCNT(b.x)], 1u);
    return b;
}
__device__ __forceinline__ void xcd_barrier_complete(unsigned* bar, unsigned x, unsigned& nloc, unsigned& nx) {
    const unsigned G = gridDim.x * gridDim.y * gridDim.z;
    unsigned sum, cnt, mine, sp = 0u;
    for (;;) {
        sum = 0u; cnt = 0u; mine = 0u;
#pragma unroll
        for (unsigned j = 0; j < 16; ++j) { const unsigned c = xb_ld(&bar[XB_XCNT(j)]); sum += c; cnt += (c > 0u) ? 1u : 0u; mine = (j == x) ? c : mine; }
        if (sum == G) break;
        __builtin_amdgcn_s_sleep(1);
        if ((++sp & 255u) == 0u) { if (xb_ld(&bar[XB_TMO])) break; if (sp > XB_SPIN_CAP) { atomicAdd(&bar[XB_TMO], 1u); break; } }
    }
    nloc = mine > 0u ? mine : 1u; nx = cnt > 0u ? cnt : 1u;
}

__device__ __forceinline__ void xcd_barrier(const XcdBarrier& b) {
    asm volatile("s_waitcnt vmcnt(0)" ::: "memory");
    __syncthreads();
    if (threadIdx.x == 0) {
        unsigned* bar = b.bar;
        __builtin_amdgcn_s_waitcnt(0);
        unsigned nloc = b.st[0], nx = b.st[1];
        if (nloc == 0u) { xcd_barrier_complete(bar, b.x, nloc, nx); b.st[0] = nloc; b.st[1] = nx; }
        const unsigned old = xb_add(&bar[XB_XSUB(b.x)], 1u);
        const unsigned gen = old / nloc;
        if (old + 1u == (gen + 1u) * nloc) {
            __builtin_amdgcn_fence(__ATOMIC_RELEASE, "agent");
            asm volatile("s_waitcnt vmcnt(0)" ::: "memory");
            const unsigned og = xb_add(&bar[XB_TOP], 1u);
            const unsigned tg = og / nx;
            if (og + 1u == (tg + 1u) * nx) xb_add(&bar[XB_TOPGEN], 1u);
            else XB_SPIN(xb_ld(&bar[XB_TOPGEN]) == tg, bar);
            __builtin_amdgcn_fence(__ATOMIC_ACQUIRE, "agent");
            xb_add(&bar[XB_XGEN(b.x)], 1u);
            asm volatile("s_waitcnt vmcnt(0)" ::: "memory");
        } else {
            XB_SPIN(xb_ld(&bar[XB_XGEN(b.x)]) == gen, bar);
            __builtin_amdgcn_fence(__ATOMIC_ACQUIRE, "agent");
            asm volatile("s_waitcnt vmcnt(0)" ::: "memory");
        }
    }
    __syncthreads();
}

template <bool SINGLE>
__global__ __launch_bounds__(512) void mega(Params P) {
  extern __shared__ __attribute__((aligned(16))) char lds[];
  const int wave_s = __builtin_amdgcn_readfirstlane((int)threadIdx.x >> 6);
  if constexpr (SINGLE) {
    cg::grid_group grid = cg::this_grid();
    __shared__ unsigned xb_st[4];
    if (threadIdx.x < 4) xb_st[threadIdx.x] = 0u;
    __syncthreads();
    const XcdBarrier xb = xcd_barrier_post((unsigned*)(P.ws + (size_t)232 * 1048576), (volatile LAS unsigned*)xb_st);
    if (P.phase_hi < 0) grid.sync();
    run_phase<0>(P, lds, wave_s); xcd_barrier(xb);
    run_phase<1>(P, lds, wave_s); xcd_barrier(xb);
    run_phase<2>(P, lds, wave_s); xcd_barrier(xb);
    run_phase<3>(P, lds, wave_s); xcd_barrier(xb);
    run_phase<4>(P, lds, wave_s); xcd_barrier(xb);
    run_phase<5>(P, lds, wave_s); xcd_barrier(xb);
    run_phase<6>(P, lds, wave_s); xcd_barrier(xb);
    run_phase<7>(P, lds, wave_s); xcd_barrier(xb);
    run_phase<8>(P, lds, wave_s); xcd_barrier(xb);
    run_phase<9>(P, lds, wave_s); xcd_barrier(xb);
    run_phase<10>(P, lds, wave_s);
  } else {
    switch (P.phase_lo) {
      case 0: run_phase<0>(P, lds, wave_s); break;
      case 1: run_phase<1>(P, lds, wave_s); break;
      case 2: run_phase<2>(P, lds, wave_s); break;
      case 3: run_phase<3>(P, lds, wave_s); break;
      case 4: run_phase<4>(P, lds, wave_s); break;
      case 5: run_phase<5>(P, lds, wave_s); break;
      case 6: run_phase<6>(P, lds, wave_s); break;
      case 7: run_phase<7>(P, lds, wave_s); break;
      case 8: run_phase<8>(P, lds, wave_s); break;
      case 9: run_phase<9>(P, lds, wave_s); break;
      default: run_phase<10>(P, lds, wave_s); break;
    }
  }
}

extern "C" void kernel_launch(void* const* d_in, const int* in_sizes, int n_in, void* d_out, int out_size, void* d_ws, size_t ws_size, hipStream_t stream) {
  static int grid = 0;
  if (grid == 0) {
    int dev = 0, cus = 0, per_cu = 0;
    hipGetDevice(&dev);
    hipDeviceGetAttribute(&cus, hipDeviceAttributeMultiprocessorCount, dev);
    if (hipFuncSetAttribute((const void*)MEGA, hipFuncAttributeMaxDynamicSharedMemorySize, LDS_BYTES) != hipSuccess) { fprintf(stderr, "hipFuncSetAttribute failed\n"); grid = -1; return; }
    hipOccupancyMaxActiveBlocksPerMultiprocessor(&per_cu, (const void*)MEGA, 512, LDS_BYTES);
    (void)hipGetLastError();
    (void)per_cu;
    grid = cus < 256 ? cus : 256;
  }
  if (grid < 0) return;
  Params p{};
  const float** f = (const float**)&p.x;
  for (int i = 0; i < 24; ++i) f[i] = (const float*)d_in[i];
  p.out = (float*)d_out;
  p.ws = (char*)d_ws;
#if ONE_LAUNCH
  p.phase_lo = 0; p.phase_hi = NPHASE;
  hipMemsetAsync((char*)d_ws + (size_t)232 * 1048576, 0, 16384, stream);
  void* args[] = {&p};
  hipError_t e = hipLaunchCooperativeKernel((const void*)MEGA, dim3(grid), dim3(512), args, LDS_BYTES, stream);
  if (e != hipSuccess) fprintf(stderr, "cooperative launch failed: %s (grid %d)\n", hipGetErrorString(e), grid);
#else
  for (int ph = 0; ph < NPHASE; ++ph) {
    p.phase_lo = ph; p.phase_hi = ph + 1;
    hipLaunchKernelGGL(MEGA, dim3(grid), dim3(512), LDS_BYTES, stream, p);
  }
#endif
}
```

```cpp
#include <hip/hip_runtime.h>
#include <hip/hip_bf16.h>
#include <hip/hip_cooperative_groups.h>
#include <cstdio>
#include <cstdint>
namespace cg = cooperative_groups;

typedef unsigned short u16;
using bf16x8 = __attribute__((ext_vector_type(8))) short;
using s16x4  = __attribute__((ext_vector_type(4))) short;
using f32x16 = __attribute__((ext_vector_type(16))) float;
using f32x4  = __attribute__((ext_vector_type(4))) float;
using u32x4  = __attribute__((ext_vector_type(4))) unsigned;
using u32x2  = __attribute__((ext_vector_type(2))) unsigned;

constexpr int DM = 1024, NB = 2, SEQ = 8192, NTOK = NB * SEQ, DEPTH = 2;
constexpr int GW = 512, DIN = 5120, DMIX = 1536, MEML = 256;
constexpr float EPS = 1e-6f;
constexpr int NPHASE = 11;
#define REP_HY 1
#define REP_OUT0 1
#define REP_CROSS 1
#define REP_NORM0 1
#define REP_ATT 1
#define REP_PROJ 1
#define REP_PREP 1
#ifndef ONE_LAUNCH
#define ONE_LAUNCH 1
#endif
#define MEGA mega<(ONE_LAUNCH != 0)>
#define MEGA mega<(ONE_LAUNCH != 0)>
#ifndef DBG_SKIP_MIX
#define DBG_SKIP_MIX 0
#endif
#ifndef DBG_NPH
#define DBG_NPH 11
#endif
#ifndef DBG_KT_LO
#define DBG_KT_LO 0
#endif
#ifndef DBG_KT_HI
#define DBG_KT_HI 24
#endif
constexpr int LDS_BYTES = 131072 + 1024;

struct Params {
  const float *x, *mem, *g_norm, *w_in, *lq1, *lk1, *lq2, *lk2, *g_sub, *conv_w, *conv_b;
  const float *hf_w1, *hf_b1, *hf_w2, *hf_b2, *hf_w3, *hf_b3, *hf_w4, *hf_freq, *hy_skip, *g_mem, *w_mem_kv, *w_out, *g_final;
  float* out;
  char* ws;
  int phase_lo, phase_hi;
#define WSF(name, type, mib) __device__ __forceinline__ type* name() const { return (type*)(ws + (size_t)(mib) * 1048576); }
  WSF(Qp, u16, 0) WSF(Kp, u16, 16) WSF(Vp, u16, 32) WSF(GAp, u16, 48) WSF(MQp, u16, 64) WSF(MGp, u16, 80) WSF(HYTp, u16, 96)
  WSF(Hp, u16, 160) WSF(YBp, u16, 160) WSF(YAp, u16, 176) WSF(WinTp, u16, 192) WSF(WoutTp, u16, 212) WSF(WmTp, u16, 218) WSF(Mnp, u16, 222) WSF(MemKVp, u16, 224)
  WSF(hdnp, float, 226) WSF(ropeCp, float, 230) WSF(ropeSp, float, 231)
#undef WSF
};

#define SBAR() __builtin_amdgcn_sched_barrier(0)
__device__ __forceinline__ int crow(int r, int hi) { return (r & 3) + 8 * (r >> 2) + 4 * hi; }
typedef __bf16 bf2_t __attribute__((ext_vector_type(2)));
typedef float fl2_t __attribute__((ext_vector_type(2)));
__device__ __forceinline__ unsigned cvtpk(float lo, float hi) {
  fl2_t f = {lo, hi};
  bf2_t b = __builtin_convertvector(f, bf2_t);
  return __builtin_bit_cast(unsigned, b);
}
__device__ __forceinline__ u16 f2bf(float x) { return __builtin_bit_cast(u16, (__bf16)x); }
__device__ __forceinline__ float bf2f(u16 v) { return __uint_as_float(((unsigned)v) << 16); }
__device__ __forceinline__ float silu(float x) { return x / (1.f + __expf(-x)); }
__device__ __forceinline__ float wave_sum(float v) {
  for (int m = 32; m >= 1; m >>= 1) v += __shfl_xor(v, m);
  return v;
}

__device__ __forceinline__ void transpose_tile(const float* __restrict__ W, u16* __restrict__ WT, int Kd, int Nd, int tk, int tn, char* lds, int TIDX) {
  u16* tile = (u16*)lds;
  const int tid = TIDX;
  const int kr = tid >> 4, nc = (tid & 15) * 4;
  __syncthreads();
#pragma unroll
  for (int i = 0; i < 2; ++i) {
    const int k = kr + 32 * i;
    const f32x4 v = *reinterpret_cast<const f32x4*>(W + (size_t)(tk * 64 + k) * Nd + tn * 64 + nc);
#pragma unroll
    for (int j = 0; j < 4; ++j) tile[(nc + j) * 72 + k] = f2bf(v[j]);
  }
  __syncthreads();
  const int n = tid >> 3, kc = (tid & 7) * 8;
  const u32x4 o = *reinterpret_cast<const u32x4*>(tile + n * 72 + kc);
  *reinterpret_cast<u32x4*>(WT + (size_t)(tn * 64 + n) * Kd + tk * 64 + kc) = o;
}

__device__ __forceinline__ void norm_row_bf16(const float* __restrict__ xr, const float* __restrict__ g, u16* __restrict__ o, int lane) {
  f32x4 v[4]; float ss = 0;
#pragma unroll
  for (int i = 0; i < 4; ++i) { v[i] = *reinterpret_cast<const f32x4*>(xr + i * 256 + lane * 4); ss += v[i][0] * v[i][0] + v[i][1] * v[i][1] + v[i][2] * v[i][2] + v[i][3] * v[i][3]; }
  ss = wave_sum(ss);
  const float rs = rsqrtf(ss * (1.f / 1024.f) + EPS);
#pragma unroll
  for (int i = 0; i < 4; ++i) {
    const f32x4 gg = *reinterpret_cast<const f32x4*>(g + i * 256 + lane * 4);
    u32x2 w = {cvtpk(v[i][0] * rs * gg[0], v[i][1] * rs * gg[1]), cvtpk(v[i][2] * rs * gg[2], v[i][3] * rs * gg[3])};
    *reinterpret_cast<u32x2*>(o + i * 256 + lane * 4) = w;
  }
}
__device__ __forceinline__ void norm_row_f32(float* __restrict__ xr, const float* __restrict__ g, int lane) {
  f32x4 v[4]; float ss = 0;
#pragma unroll
  for (int i = 0; i < 4; ++i) { v[i] = *reinterpret_cast<const f32x4*>(xr + i * 256 + lane * 4); ss += v[i][0] * v[i][0] + v[i][1] * v[i][1] + v[i][2] * v[i][2] + v[i][3] * v[i][3]; }
  ss = wave_sum(ss);
  const float rs = rsqrtf(ss * (1.f / 1024.f) + EPS);
#pragma unroll
  for (int i = 0; i < 4; ++i) {
    const f32x4 gg = *reinterpret_cast<const f32x4*>(g + i * 256 + lane * 4);
    f32x4 w = {v[i][0] * rs * gg[0], v[i][1] * rs * gg[1], v[i][2] * rs * gg[2], v[i][3] * rs * gg[3]};
    *reinterpret_cast<f32x4*>(xr + i * 256 + lane * 4) = w;
  }
}

__device__ __forceinline__ void phase_prep(const Params& P, char* lds, int TIDX, int BIDX) {
  const int tid = TIDX, wid = tid >> 6, lane = tid & 63;
  const int nb = gridDim.x, bid = BIDX;
  {
    constexpr int U_IN = (DIN / 512) * (DM / 32), U_OUT = (DM / 512) * (DMIX / 32), U_M = (DM / 512) * (DM / 32);
    constexpr int U_L = U_IN + U_OUT + U_M;
    for (int it = bid; it < DEPTH * U_L; it += nb) {
      const int l = it / U_L; int r = it % U_L;
      const float* W; u16* WT; int Kd, Nd;
      if (r < U_IN) { W = P.w_in + (size_t)l * DM * DIN; WT = P.WinTp() + (size_t)l * DIN * DM; Kd = DM; Nd = DIN; }
      else if (r < U_IN + U_OUT) { r -= U_IN; W = P.w_out + (size_t)l * DMIX * DM; WT = P.WoutTp() + (size_t)l * DM * DMIX; Kd = DMIX; Nd = DM; }
      else { r -= U_IN + U_OUT; W = P.w_mem_kv + (size_t)l * DM * DM; WT = P.WmTp() + (size_t)l * DM * DM; Kd = DM; Nd = DM; }
      const int nkb = Kd / 32, nblk = r / nkb, kb = r % nkb;
      const int n = nblk * 512 + tid, k0 = kb * 32;
      const float* src = W + (size_t)k0 * Nd + n;
      float v[32];
#pragma unroll
      for (int k = 0; k < 32; ++k) v[k] = src[(size_t)k * Nd];
      u16* dst = WT + (size_t)n * Kd + k0;
#pragma unroll
      for (int c = 0; c < 4; ++c) {
        u32x4 o = {cvtpk(v[c * 8 + 0], v[c * 8 + 1]), cvtpk(v[c * 8 + 2], v[c * 8 + 3]), cvtpk(v[c * 8 + 4], v[c * 8 + 5]), cvtpk(v[c * 8 + 6], v[c * 8 + 7])};
        *reinterpret_cast<u32x4*>(dst + c * 8) = o;
      }
    }
  }
  for (int it = bid; it < NTOK / 8; it += nb) { const int row = it * 8 + wid; norm_row_bf16(P.x + (size_t)row * DM, P.g_norm, P.Hp() + (size_t)row * DM, lane); }
  for (int it = bid; it < DEPTH * NB * MEML / 8; it += nb) {
    const int r = it * 8 + wid, l = r / (NB * MEML), row = r % (NB * MEML);
    norm_row_bf16(P.mem + (size_t)row * DM, P.g_mem + l * DM, P.Mnp() + (size_t)r * DM, lane);
  }
  for (int gg = bid * 8 + wid; gg < DEPTH * SEQ / 8; gg += nb * 8) {
    const int r0 = gg * 8, l = r0 / SEQ, t0 = r0 % SEQ;
    float zf[8];
#pragma unroll
    for (int r = 0; r < 8; ++r) {
      const int tt = t0 + r; float z = 0.f;
      if (lane == 0) z = (float)tt * (1.f / 8191.f);
      else if (lane < 33) {
        const int i = (lane - 1) & 15;
        const float f = 1e-4f + (float)i * ((15.f - 1e-4f) / 15.f);
        const float w = (6.283185307179586f * (float)tt) / 8192.f;
        z = (lane <= 16) ? cosf(f * w) : -sinf(f * w);
      }
      zf[r] = z;
    }
    const float fr = P.hf_freq[l * 64 + lane];
    float a[8], h[8];
    { const float b = P.hf_b1[l * 64 + lane];
#pragma unroll
      for (int r = 0; r < 8; ++r) a[r] = b; }
#pragma unroll 3
    for (int i = 0; i < 33; ++i) { const float w = P.hf_w1[(l * 33 + i) * 64 + lane];
#pragma unroll
      for (int r = 0; r < 8; ++r) a[r] += __int_as_float(__builtin_amdgcn_readlane(__float_as_int(zf[r]), i)) * w; }
#pragma unroll
    for (int r = 0; r < 8; ++r) h[r] = sinf(fr * a[r]);
    { const float b = P.hf_b2[l * 64 + lane];
#pragma unroll
      for (int r = 0; r < 8; ++r) a[r] = b; }
#pragma unroll 4
    for (int i = 0; i < 64; ++i) { const float w = P.hf_w2[(l * 64 + i) * 64 + lane];
#pragma unroll
      for (int r = 0; r < 8; ++r) a[r] += __int_as_float(__builtin_amdgcn_readlane(__float_as_int(h[r]), i)) * w; }
#pragma unroll
    for (int r = 0; r < 8; ++r) h[r] = sinf(fr * a[r]);
    { const float b = P.hf_b3[l * 64 + lane];
#pragma unroll
      for (int r = 0; r < 8; ++r) a[r] = b; }
#pragma unroll 4
    for (int i = 0; i < 64; ++i) { const float w = P.hf_w3[(l * 64 + i) * 64 + lane];
#pragma unroll
      for (int r = 0; r < 8; ++r) a[r] += __int_as_float(__builtin_amdgcn_readlane(__float_as_int(h[r]), i)) * w; }
    u16* o = reinterpret_cast<u16*>(P.hdnp()) + ((size_t)l * SEQ + t0) * 64 + lane;
#pragma unroll
    for (int r = 0; r < 8; ++r) o[r * 64] = f2bf(sinf(fr * a[r]));
  }
  for (int idx = bid * 512 + tid; idx < SEQ * 32; idx += nb * 512) {
    const int pos = idx >> 5, j = idx & 31;
    const float inv = powf(10000.f, -((float)(2 * j) / 64.f));
    const float ang = (float)pos * inv;
    P.ropeCp()[idx] = cosf(ang); P.ropeSp()[idx] = sinf(ang);
  }
}

__device__ __forceinline__ int g_lds_off(int row, int ch) { return row * 128 + ((ch ^ ((row >> 1) & 7)) << 4); }

template <int MODE>
__device__ __forceinline__ void gemm_tile(const Params& P, int layer, int m0, int n0, char* lds, int TIDX, bool preloaded = false, int nm0 = -1, int nn0 = 0) {
  int tid = TIDX; asm volatile("" : "+v"(tid));
  const int wid = tid >> 6, lane = tid & 63, r32 = lane & 31, hi = lane >> 5;
  const int wm = wid >> 2, wn = wid & 3;
  constexpr int K = (MODE == 1) ? DMIX : DM;
  constexpr int NK = K / 64;
  const u16* Bt = (MODE == 0) ? P.WinTp() + (size_t)layer * DIN * DM : (MODE == 1) ? P.WoutTp() + (size_t)layer * DM * DMIX : P.WmTp() + (size_t)layer * DM * DM;
  const int srow = tid >> 3, sch = tid & 7;
  f32x16 acc[4][2];
#pragma unroll
  for (int a = 0; a < 4; ++a)
#pragma unroll
    for (int b = 0; b < 2; ++b) acc[a][b] = f32x16{};
  u32x4 ra[4], rb[4];
  auto a_ptr = [&](int kt, int mm) -> const u16* {
    if (MODE == 0) return P.Hp() + (size_t)mm * DM + kt * 64;
    if (MODE == 2) return P.Mnp() + ((size_t)layer * NB * MEML + mm) * DM + kt * 64;
    const int src = kt >> 3, ko = (kt & 7) * 64;
    const u16* b = (src == 0) ? P.YAp() : (src == 1) ? P.YBp() : P.GAp();
    return b + (size_t)mm * GW + ko;
  };
  constexpr int LDA = (MODE == 1) ? GW : DM;
#define G_LOAD_AT(kt, mm, nn) do { const u16* ap = a_ptr(kt, mm); const u16* bp = Bt + (size_t)(nn) * K + (kt) * 64;                       \
    _Pragma("unroll") for (int i = 0; i < 4; ++i) {                                                                      \
      ra[i] = *reinterpret_cast<const u32x4*>(ap + (size_t)(srow + i * 64) * LDA + sch * 8);                            \
      rb[i] = *reinterpret_cast<const u32x4*>(bp + (size_t)(srow + i * 64) * K + sch * 8); } } while (0)
#define G_WRITE(buf) do { char* la = lds + (buf) * 65536; char* lb = la + 32768;                                          \
    _Pragma("unroll") for (int i = 0; i < 4; ++i) {                                                                      \
      *reinterpret_cast<u32x4*>(la + g_lds_off(srow + i * 64, sch)) = ra[i];                                             \
      *reinterpret_cast<u32x4*>(lb + g_lds_off(srow + i * 64, sch)) = rb[i]; } } while (0)
#define G_LOAD(kt) G_LOAD_AT(kt, m0, n0)
  constexpr int KT0 = 0, KT1 = NK;
  if (!preloaded) { __syncthreads(); G_LOAD(KT0); G_WRITE(KT0 & 1); }
  __syncthreads();
  for (int kt = KT0; kt < KT1; ++kt) {
    if (kt + 1 < KT1) G_LOAD(kt + 1);
    const char* la = lds + (kt & 1) * 65536; const char* lb = la + 32768;
#pragma unroll
    for (int ks = 0; ks < 4; ++ks) {
      bf16x8 af[4], bfr[2];
#pragma unroll
      for (int mb = 0; mb < 4; ++mb) af[mb] = *reinterpret_cast<const bf16x8*>(la + g_lds_off(wm * 128 + mb * 32 + r32, ks * 2 + hi));
#pragma unroll
      for (int nb2 = 0; nb2 < 2; ++nb2) bfr[nb2] = *reinterpret_cast<const bf16x8*>(lb + g_lds_off(wn * 64 + nb2 * 32 + r32, ks * 2 + hi));
#pragma unroll
      for (int mb = 0; mb < 4; ++mb)
#pragma unroll
        for (int nb2 = 0; nb2 < 2; ++nb2) acc[mb][nb2] = __builtin_amdgcn_mfma_f32_32x32x16_bf16(af[mb], bfr[nb2], acc[mb][nb2], 0, 0, 0);
    }
    if (kt + 1 < KT1) G_WRITE((kt + 1) & 1);
    __syncthreads();
  }
  if (nm0 >= 0) G_LOAD_AT(0, nm0, nn0);
  const int rbase = m0 + wm * 128, cbase = n0 + wn * 64;
  if (MODE == 1) {
    const float* xin = (layer == 0) ? P.x : P.out;
#pragma unroll
    for (int mb = 0; mb < 4; ++mb)
#pragma unroll
      for (int r = 0; r < 16; ++r) {
        const size_t row = rbase + mb * 32 + crow(r, hi);
#pragma unroll
        for (int nb2 = 0; nb2 < 2; ++nb2) { const size_t idx = row * DM + cbase + nb2 * 32 + r32; P.out[idx] = xin[idx] + acc[mb][nb2][r]; }
      }
  } else if (MODE == 2) {
    u16* o = P.MemKVp() + (size_t)layer * NB * MEML * DM;
#pragma unroll
    for (int mb = 0; mb < 4; ++mb)
#pragma unroll
      for (int r = 0; r < 16; ++r) {
        const size_t row = rbase + mb * 32 + crow(r, hi);
#pragma unroll
        for (int nb2 = 0; nb2 < 2; ++nb2) o[row * DM + cbase + nb2 * 32 + r32] = f2bf(acc[mb][nb2][r]);
      }
  } else {
    const int region = n0 >> 9;
    const int cl = (cbase & 511);
    if (region <= 1) {
      u16* o = (region == 0) ? P.Qp() : P.Kp();
#pragma unroll
      for (int mb = 0; mb < 4; ++mb)
#pragma unroll
        for (int r = 0; r < 16; ++r) {
          const int row = rbase + mb * 32 + crow(r, hi);
          const int pos = row & (SEQ - 1);
          const float c = P.ropeCp()[pos * 32 + r32], s = P.ropeSp()[pos * 32 + r32];
          const float x1 = acc[mb][0][r], x2 = acc[mb][1][r];
          const float qs = (region == 0) ? 0.125f * 1.4426950408889634f : 1.f;
          o[(size_t)row * GW + cl + r32] = f2bf((x1 * c - x2 * s) * qs);
          o[(size_t)row * GW + cl + 32 + r32] = f2bf((x2 * c + x1 * s) * qs);
        }
    } else if (region >= 4 && region <= 7) {
      const int hc0 = cbase - 2048;
#pragma unroll
      for (int mb = 0; mb < 4; ++mb)
#pragma unroll
        for (int nb2 = 0; nb2 < 2; ++nb2)
#pragma unroll
          for (int g = 0; g < 4; ++g) {
            const int row = rbase + mb * 32 + 8 * g + 4 * hi;
            const int b = row >> 13, s = row & (SEQ - 1);
            u32x2 w = {cvtpk(acc[mb][nb2][4 * g], acc[mb][nb2][4 * g + 1]), cvtpk(acc[mb][nb2][4 * g + 2], acc[mb][nb2][4 * g + 3])};
            *reinterpret_cast<u32x2*>(P.HYTp() + ((size_t)(b * 2048 + hc0 + nb2 * 32 + r32)) * SEQ + s) = w;
          }
    } else {
      u16* o = P.Qp() + (size_t)((region >= 8) ? region - 4 : region) * ((size_t)NTOK * GW);
#pragma unroll
      for (int mb = 0; mb < 4; ++mb)
#pragma unroll
        for (int r = 0; r < 16; ++r) {
          const size_t row = rbase + mb * 32 + crow(r, hi);
#pragma unroll
          for (int nb2 = 0; nb2 < 2; ++nb2) o[row * GW + cl + nb2 * 32 + r32] = f2bf(acc[mb][nb2][r] * ((region == 8) ? 0.088388347648318440f * 1.4426950408889634f : 1.f));
        }
    }
  }
  if (nm0 >= 0) G_WRITE(0);
#undef G_LOAD
#undef G_LOAD_AT
#undef G_WRITE
}

constexpr int KVBLK = 64;
constexpr size_t SHM_V = KVBLK * 128 * 2, SHM_K = KVBLK * 128 * 2;
constexpr float THR = 8.f;
#define KSWZ(row, colB) ((row) * 256 + ((colB) ^ (((row) & 7) << 4)))

template <int SCALE_I>
struct ScaleC {};

constexpr float THRL = 8.f * 1.4426950408889634f;
__device__ __forceinline__ void partialSM_first(f32x16& p0, f32x16& p1, float& m_reg, float& alpha) {
  float pmax = p0[0];
#pragma unroll
  for (int r = 1; r < 16; ++r) pmax = fmaxf(pmax, p0[r]);
#pragma unroll
  for (int r = 0; r < 16; ++r) pmax = fmaxf(pmax, p1[r]);
  { auto rr = __builtin_amdgcn_permlane32_swap(__float_as_uint(pmax), __float_as_uint(pmax), false, false);
    pmax = fmaxf(__uint_as_float(rr[0]), __uint_as_float(rr[1])); }
  m_reg += pmax; alpha = 1.f;
#pragma unroll
  for (int r = 0; r < 16; ++r) p0[r] -= pmax;
#pragma unroll
  for (int r = 0; r < 16; ++r) p1[r] -= pmax;
#pragma unroll
  for (int r = 0; r < 16; ++r) p0[r] = __builtin_amdgcn_exp2f(p0[r]);
}
__device__ __forceinline__ void finishSM(f32x16& p0, f32x16& p1, float alpha, float& l_reg, bf16x8& pa0, bf16x8& pa1, bf16x8& pa2, bf16x8& pa3) {
#pragma unroll
  for (int r = 0; r < 16; ++r) p1[r] = __builtin_amdgcn_exp2f(p1[r]);
  float ps = 0;
#pragma unroll
  for (int r = 0; r < 16; ++r) ps += p0[r];
#pragma unroll
  for (int r = 0; r < 16; ++r) ps += p1[r];
  { auto rr = __builtin_amdgcn_permlane32_swap(__float_as_uint(ps), __float_as_uint(ps), false, false);
    ps = __uint_as_float(rr[0]) + __uint_as_float(rr[1]); }
  l_reg = l_reg * alpha + ps;
#define PK4(P, BASE, OUT) do { unsigned a0 = cvtpk(P[BASE + 0], P[BASE + 1]), a1 = cvtpk(P[BASE + 2], P[BASE + 3]);   \
    unsigned b0 = cvtpk(P[BASE + 4], P[BASE + 5]), b1 = cvtpk(P[BASE + 6], P[BASE + 7]);                              \
    auto r0 = __builtin_amdgcn_permlane32_swap(a0, b0, false, false); auto r1 = __builtin_amdgcn_permlane32_swap(a1, b1, false, false); \
    u32x4 w = {r0[0], r1[0], r0[1], r1[1]}; OUT = *reinterpret_cast<bf16x8*>(&w); } while (0)
  PK4(p0, 0, pa0); PK4(p0, 8, pa1); PK4(p1, 0, pa2); PK4(p1, 8, pa3);
#undef PK4
}
template <int NKS>
__device__ __forceinline__ void qkt(f32x16& p0, f32x16& p1, const char* Ks, const bf16x8* qr, int r32, int hi, int kcolB, float minit) {
#pragma unroll
  for (int r = 0; r < 16; ++r) { p0[r] = minit; p1[r] = minit; }
#pragma unroll
  for (int d0 = 0; d0 < NKS; ++d0) { const int cb = kcolB + (d0 * 16 + hi * 8) * 2;
    bf16x8 b0 = *reinterpret_cast<const bf16x8*>(Ks + KSWZ(r32, cb));
    bf16x8 b1 = *reinterpret_cast<const bf16x8*>(Ks + KSWZ(32 + r32, cb));
    p0 = __builtin_amdgcn_mfma_f32_32x32x16_bf16(b0, qr[d0], p0, 0, 0, 0);
    p1 = __builtin_amdgcn_mfma_f32_32x32x16_bf16(b1, qr[d0], p1, 0, 0, 0); }
}
__device__ __forceinline__ int v_st(int k, int c) { const int kk = (k & ~0xC) | ((k & 4) << 1) | ((k & 8) >> 1); return ((kk >> 3) * 4 + (c >> 5)) * 512 + ((kk & 7) * 32 + (c & 31)) * 2; }
__device__ __forceinline__ int v_rd_base(int lane) { return ((lane & 3) << 3) | (((lane >> 2) & 3) << 6) | (((lane >> 4) & 1) << 5) | (((lane >> 5) & 1) << 8); }
constexpr int v_rd_off(int d0, int ks, int half) { return d0 * 512 + ks * 4096 + half * 2048; }
template <int OFF> __device__ __forceinline__ s16x4 tr_read(int vb) {
  s16x4 r; asm volatile("ds_read_b64_tr_b16 %0, %1 offset:%2" : "=&v"(r) : "v"(vb), "i"(OFF) : "memory"); return r;
}
template <int D0> __device__ __forceinline__ void pv_one(f32x16& od, int vb, bf16x8 pa0, bf16x8 pa1, bf16x8 pa2, bf16x8 pa3) {
  const s16x4 l0 = tr_read<v_rd_off(D0, 0, 0)>(vb), h0 = tr_read<v_rd_off(D0, 0, 1)>(vb), l1 = tr_read<v_rd_off(D0, 1, 0)>(vb), h1 = tr_read<v_rd_off(D0, 1, 1)>(vb);
  const s16x4 l2 = tr_read<v_rd_off(D0, 2, 0)>(vb), h2 = tr_read<v_rd_off(D0, 2, 1)>(vb), l3 = tr_read<v_rd_off(D0, 3, 0)>(vb), h3 = tr_read<v_rd_off(D0, 3, 1)>(vb);
  asm volatile("s_waitcnt lgkmcnt(0)" ::: "memory"); SBAR();
#define PK(L, H) (bf16x8){L[0], L[1], L[2], L[3], H[0], H[1], H[2], H[3]}
  od = __builtin_amdgcn_mfma_f32_32x32x16_bf16(pa0, PK(l0, h0), od, 0, 0, 0);
  od = __builtin_amdgcn_mfma_f32_32x32x16_bf16(pa1, PK(l1, h1), od, 0, 0, 0);
  od = __builtin_amdgcn_mfma_f32_32x32x16_bf16(pa2, PK(l2, h2), od, 0, 0, 0);
  od = __builtin_amdgcn_mfma_f32_32x32x16_bf16(pa3, PK(l3, h3), od, 0, 0, 0);
#undef PK
}
__device__ __forceinline__ void pv_d0(f32x16* o, int vb, bf16x8 pa0, bf16x8 pa1, bf16x8 pa2, bf16x8 pa3) {
  pv_one<0>(o[0], vb, pa0, pa1, pa2, pa3); pv_one<1>(o[1], vb, pa0, pa1, pa2, pa3); pv_one<2>(o[2], vb, pa0, pa1, pa2, pa3); pv_one<3>(o[3], vb, pa0, pa1, pa2, pa3);
}

struct VFrag { s16x4 l0, h0, l1, h1, l2, h2, l3, h3; };
template <int D0> __device__ __forceinline__ void pv_ld(VFrag& f, int vb) {
  f.l0 = tr_read<v_rd_off(D0, 0, 0)>(vb); f.h0 = tr_read<v_rd_off(D0, 0, 1)>(vb); f.l1 = tr_read<v_rd_off(D0, 1, 0)>(vb); f.h1 = tr_read<v_rd_off(D0, 1, 1)>(vb);
  f.l2 = tr_read<v_rd_off(D0, 2, 0)>(vb); f.h2 = tr_read<v_rd_off(D0, 2, 1)>(vb); f.l3 = tr_read<v_rd_off(D0, 3, 0)>(vb); f.h3 = tr_read<v_rd_off(D0, 3, 1)>(vb);
}
__device__ __forceinline__ void pv_mm(f32x16& od, const VFrag& f, bf16x8 pa0, bf16x8 pa1, bf16x8 pa2, bf16x8 pa3) {
#define PK(L, H) (bf16x8){L[0], L[1], L[2], L[3], H[0], H[1], H[2], H[3]}
  od = __builtin_amdgcn_mfma_f32_32x32x16_bf16(pa0, PK(f.l0, f.h0), od, 0, 0, 0);
  od = __builtin_amdgcn_mfma_f32_32x32x16_bf16(pa1, PK(f.l1, f.h1), od, 0, 0, 0);
  od = __builtin_amdgcn_mfma_f32_32x32x16_bf16(pa2, PK(f.l2, f.h2), od, 0, 0, 0);
  od = __builtin_amdgcn_mfma_f32_32x32x16_bf16(pa3, PK(f.l3, f.h3), od, 0, 0, 0);
#undef PK
}
template <bool PIPE>
__device__ __forceinline__ void pv_sm(f32x16* o, int vb, bf16x8 pa0, bf16x8 pa1, bf16x8 pa2, bf16x8 pa3,
                                      f32x16& p0, f32x16& p1, float& m_reg, float& alpha) {
  if constexpr (!PIPE) {
    pv_one<0>(o[0], vb, pa0, pa1, pa2, pa3);
    float pmax = p0[0];
#pragma unroll
    for (int r = 1; r < 16; ++r) pmax = fmaxf(pmax, p0[r]);
    pv_one<1>(o[1], vb, pa0, pa1, pa2, pa3);
#pragma unroll
    for (int r = 0; r < 16; ++r) pmax = fmaxf(pmax, p1[r]);
    { auto rr = __builtin_amdgcn_permlane32_swap(__float_as_uint(pmax), __float_as_uint(pmax), false, false);
      pmax = fmaxf(__uint_as_float(rr[0]), __uint_as_float(rr[1])); }
    pv_one<2>(o[2], vb, pa0, pa1, pa2, pa3);
    if (__builtin_expect(__all(pmax <= THRL), 1)) { alpha = 1.f; }
    else {
      const float dl = fmaxf(pmax, 0.f);
      alpha = __builtin_amdgcn_exp2f(-dl); m_reg += dl;
#pragma unroll
      for (int r = 0; r < 16; ++r) p0[r] -= dl;
#pragma unroll
      for (int r = 0; r < 16; ++r) p1[r] -= dl;
    }
    pv_one<3>(o[3], vb, pa0, pa1, pa2, pa3);
#pragma unroll
    for (int r = 0; r < 16; ++r) p0[r] = __builtin_amdgcn_exp2f(p0[r]);
    return;
  }
  struct HF { s16x4 l0, h0, l1, h1; } f0, f1, f2;
#define LDH(F, D0, H) do { F.l0 = tr_read<v_rd_off(D0, 2 * (H), 0)>(vb); F.h0 = tr_read<v_rd_off(D0, 2 * (H), 1)>(vb); \
                           F.l1 = tr_read<v_rd_off(D0, 2 * (H) + 1, 0)>(vb); F.h1 = tr_read<v_rd_off(D0, 2 * (H) + 1, 1)>(vb); } while (0)
#define PKH(L, H) (bf16x8){L[0], L[1], L[2], L[3], H[0], H[1], H[2], H[3]}
#define MMH(OD, F, PX, PY) do { OD = __builtin_amdgcn_mfma_f32_32x32x16_bf16(PX, PKH(F.l0, F.h0), OD, 0, 0, 0); \
                                OD = __builtin_amdgcn_mfma_f32_32x32x16_bf16(PY, PKH(F.l1, F.h1), OD, 0, 0, 0); } while (0)
#define WAITL(n) do { asm volatile("s_waitcnt lgkmcnt(" #n ")" ::: "memory"); SBAR(); } while (0)
  LDH(f0, 0, 0); LDH(f1, 0, 1); LDH(f2, 1, 0);
  WAITL(8); MMH(o[0], f0, pa0, pa1); SBAR(); LDH(f0, 1, 1);
  WAITL(8); MMH(o[0], f1, pa2, pa3);
  float pmax = p0[0];
#pragma unroll
  for (int r = 1; r < 16; ++r) pmax = fmaxf(pmax, p0[r]);
  SBAR(); LDH(f1, 2, 0);
  WAITL(8); MMH(o[1], f2, pa0, pa1); SBAR(); LDH(f2, 2, 1);
  WAITL(8); MMH(o[1], f0, pa2, pa3);
#pragma unroll
  for (int r = 0; r < 16; ++r) pmax = fmaxf(pmax, p1[r]);
  { auto rr = __builtin_amdgcn_permlane32_swap(__float_as_uint(pmax), __float_as_uint(pmax), false, false);
    pmax = fmaxf(__uint_as_float(rr[0]), __uint_as_float(rr[1])); }
  SBAR(); LDH(f0, 3, 0);
  WAITL(8); MMH(o[2], f1, pa0, pa1); SBAR(); LDH(f1, 3, 1);
  WAITL(8); MMH(o[2], f2, pa2, pa3);
  if (__builtin_expect(__all(pmax <= THRL), 1)) { alpha = 1.f; }
  else {
    const float dl = fmaxf(pmax, 0.f);
    alpha = __builtin_amdgcn_exp2f(-dl); m_reg += dl;
#pragma unroll
    for (int r = 0; r < 16; ++r) p0[r] -= dl;
#pragma unroll
    for (int r = 0; r < 16; ++r) p1[r] -= dl;
  }
  WAITL(4); MMH(o[3], f0, pa0, pa1);
  WAITL(0); MMH(o[3], f1, pa2, pa3);
#pragma unroll
  for (int r = 0; r < 16; ++r) p0[r] = __builtin_amdgcn_exp2f(p0[r]);
#undef LDH
#undef PKH
#undef MMH
#undef WAITL
}

template <bool DIFF>
__device__ __forceinline__ void attn_item(const Params& P, int layer, const u16* __restrict__ Qlane, const u16* __restrict__ Kh, const u16* __restrict__ Vh,
                                          int seq, int tok0, int hcol, float lam, float post, char* lds, int TIDX) {
  constexpr int NKS = DIFF ? 4 : 8;
  constexpr int LDK = DIFF ? GW : DM;
  int tid = TIDX; asm volatile("" : "+v"(tid));
  const int wid = tid >> 6, lane = tid & 63, r32 = lane & 31, hi = lane >> 5;
  const int mp = DIFF ? (wid >> 2) : 0;
  char* V_lds = lds; char* K_lds = lds + 3 * SHM_V;
  float* ws = (float*)(lds + 3 * SHM_V + 3 * SHM_K) + wid * 64; float* li_l = ws; float* al_l = ws + 32;
  float m_reg = 0.f, l_reg = 0; f32x16 o[4];
#pragma unroll
  for (int d = 0; d < 4; ++d) o[d] = f32x16{};
  bf16x8 qr[NKS];
#pragma unroll
  for (int d0 = 0; d0 < NKS; ++d0) qr[d0] = *reinterpret_cast<const bf16x8*>(Qlane + d0 * 16);
  const int kcolB = mp * 128;
  const int sr = tid >> 4, sc = (tid & 15) * 8, vst0 = v_st(sr, sc), vst1 = v_st(32 + sr, sc);
  const int vb0 = (int)(uintptr_t)V_lds + v_rd_base(lane);
  constexpr int SD = DIFF ? 2 : 1;
  struct { bf16x8 vs0, vs1, ks0, ks1; } sr_[SD];
#define SLOAD(i, k0) do { sr_[i].vs0 = *reinterpret_cast<const bf16x8*>(&Vh[(long)((k0) + sr) * LDK + sc]); sr_[i].vs1 = *reinterpret_cast<const bf16x8*>(&Vh[(long)((k0) + 32 + sr) * LDK + sc]); \
    sr_[i].ks0 = *reinterpret_cast<const bf16x8*>(&Kh[(long)((k0) + sr) * LDK + sc]); sr_[i].ks1 = *reinterpret_cast<const bf16x8*>(&Kh[(long)((k0) + 32 + sr) * LDK + sc]); } while (0)
#define SWRITE(b, i) do { *(bf16x8*)(V_lds + (b) * SHM_V + vst0) = sr_[i].vs0;          \
    *(bf16x8*)(V_lds + (b) * SHM_V + vst1) = sr_[i].vs1; int kc = sc * 2;               \
    *(bf16x8*)(K_lds + (b) * SHM_K + KSWZ(sr, kc)) = sr_[i].ks0;                       \
    *(bf16x8*)(K_lds + (b) * SHM_K + KSWZ(32 + sr, kc)) = sr_[i].ks1; } while (0)
#define SWAIT() do { if constexpr (SD == 2) asm volatile("s_waitcnt vmcnt(4)" ::: "memory"); else asm volatile("s_waitcnt vmcnt(0)" ::: "memory"); } while (0)
#define RESC(a) do { if (__any((a) < 1.f)) { if (hi == 0) al_l[r32] = (a); asm volatile("s_waitcnt lgkmcnt(0)" ::: "memory"); \
    _Pragma("unroll") for (int d = 0; d < 4; ++d) _Pragma("unroll") for (int r = 0; r < 16; ++r) o[d][r] *= al_l[crow(r, hi)]; } } while (0)
  f32x16 pA0, pA1, pB0, pB1; float alA, alB; bf16x8 pa0, pa1, pa2, pa3; const int NT = seq / KVBLK;
  constexpr int SE = 0, SO = SD - 1;
  __syncthreads();
  SLOAD(SE, 0); asm volatile("s_waitcnt vmcnt(0)" ::: "memory"); SWRITE(0, SE); __syncthreads();
  qkt<NKS>(pA0, pA1, K_lds, qr, r32, hi, kcolB, 0.f); partialSM_first(pA0, pA1, m_reg, alA);
  SLOAD(SO, KVBLK); if constexpr (SD == 2) { if (2 < NT) SLOAD(SE, 2 * KVBLK); }
  SWAIT(); SWRITE(1, SO); __syncthreads();
  int bp = 0, bc = 1;
  for (int j = 1; j + 1 < NT; j += 2) {
    int bn = (bc == 2) ? 0 : bc + 1;
    SBAR(); qkt<NKS>(pB0, pB1, K_lds + bc * (int)SHM_K, qr, r32, hi, kcolB, -m_reg);
    finishSM(pA0, pA1, alA, l_reg, pa0, pa1, pa2, pa3); SBAR();
    SLOAD(SO, (j + SD) * KVBLK); SBAR();
    if constexpr (SD == 2) { SWAIT(); SWRITE(bn, SE); SBAR(); }
    pv_sm<DIFF>(o, vb0 + bp * (int)SHM_V, pa0, pa1, pa2, pa3, pB0, pB1, m_reg, alB);
    if constexpr (SD == 1) { SWAIT(); SWRITE(bn, SE); }
    RESC(alB); __syncthreads();
    bp = bc; bc = bn; bn = (bc == 2) ? 0 : bc + 1;
    SBAR(); qkt<NKS>(pA0, pA1, K_lds + bc * (int)SHM_K, qr, r32, hi, kcolB, -m_reg);
    finishSM(pB0, pB1, alB, l_reg, pa0, pa1, pa2, pa3); SBAR();
    if (SD == 1 || j + 3 < NT) SLOAD(SE, (j + 1 + SD) * KVBLK); SBAR();
    if constexpr (SD == 2) { SWAIT(); SWRITE(bn, SO); SBAR(); }
    pv_sm<DIFF>(o, vb0 + bp * (int)SHM_V, pa0, pa1, pa2, pa3, pA0, pA1, m_reg, alA);
    if constexpr (SD == 1) { SWAIT(); SWRITE(bn, SO); }
    RESC(alA); __syncthreads();
    bp = bc; bc = bn;
  }
  SBAR(); qkt<NKS>(pB0, pB1, K_lds + bc * (int)SHM_K, qr, r32, hi, kcolB, -m_reg);
  finishSM(pA0, pA1, alA, l_reg, pa0, pa1, pa2, pa3); SBAR();
  pv_sm<DIFF>(o, vb0 + bp * (int)SHM_V, pa0, pa1, pa2, pa3, pB0, pB1, m_reg, alB);
  RESC(alB);
  finishSM(pB0, pB1, alB, l_reg, pa0, pa1, pa2, pa3); SBAR();
  pv_d0(o, vb0 + bc * (int)SHM_V, pa0, pa1, pa2, pa3);
  if (hi == 0) li_l[r32] = l_reg; asm volatile("s_waitcnt lgkmcnt(0)" ::: "memory");
  float rli[16];
#pragma unroll
  for (int r = 0; r < 16; ++r) rli[r] = __builtin_amdgcn_rcpf(li_l[crow(r, hi)]);
  if (DIFF) {
    const int qw = wid & 3;
    float* X = (float*)lds;
    __syncthreads();
    if (mp == 1) {
#pragma unroll
      for (int r = 0; r < 16; ++r)
#pragma unroll
        for (int d0 = 0; d0 < 4; ++d0) X[(qw * 32 + crow(r, hi)) * 128 + d0 * 32 + r32] = o[d0][r] * rli[r];
    }
    __syncthreads();
    if (mp == 0) {
      float ss[16];
#pragma unroll
      for (int r = 0; r < 16; ++r) {
        float s2 = 0;
#pragma unroll
        for (int d0 = 0; d0 < 4; ++d0) { const float v = o[d0][r] * rli[r] - lam * X[(qw * 32 + crow(r, hi)) * 128 + d0 * 32 + r32]; o[d0][r] = v; s2 += v * v; }
        ss[r] = s2;
      }
#pragma unroll
      for (int r = 0; r < 16; ++r) {
#pragma unroll
        for (int m = 16; m >= 1; m >>= 1) ss[r] += __shfl_xor(ss[r], m);
      }
      float gs[4];
#pragma unroll
      for (int d0 = 0; d0 < 4; ++d0) gs[d0] = P.g_sub[layer * 128 + d0 * 32 + r32] * post;
#pragma unroll
      for (int r = 0; r < 16; ++r) {
        const float rs = rsqrtf(ss[r] * (1.f / 128.f) + EPS);
        const size_t tok = tok0 + crow(r, hi);
#pragma unroll
        for (int d0 = 0; d0 < 4; ++d0) {
          const size_t idx = tok * GW + hcol + d0 * 32 + r32;
          const float g = bf2f(P.GAp()[idx]);
          P.YAp()[idx] = f2bf(o[d0][r] * rs * gs[d0] * silu(g));
        }
      }
    }
    __syncthreads();
  } else {
#pragma unroll
    for (int r = 0; r < 16; ++r) {
      const size_t tok = tok0 + crow(r, hi);
#pragma unroll
      for (int d0 = 0; d0 < 4; ++d0) {
        const size_t idx = tok * GW + hcol + d0 * 32 + r32;
        const float g = bf2f(P.MGp()[idx]);
        P.GAp()[idx] = f2bf(o[d0][r] * rli[r] * silu(g));
      }
    }
    __syncthreads();
  }
#undef SLOAD
#undef SWRITE
#undef SWAIT
#undef RESC
}

__device__ __forceinline__ void phase_attn(const Params& P, int layer, char* lds, int TIDX, int BIDX) {
  const int wid = TIDX >> 6, lane = TIDX & 63, r32 = lane & 31, hi = lane >> 5;
  float d1 = P.lq1[layer * 64 + lane] * P.lk1[layer * 64 + lane], d2 = P.lq2[layer * 64 + lane] * P.lk2[layer * 64 + lane];
  d1 = wave_sum(d1); d2 = wave_sum(d2);
  const float lam_init = 0.8f - 0.6f * expf(-0.3f * (float)layer);
  const float lam = expf(d1) - expf(d2) + lam_init;
  const float post = 1.f - lam_init;
  const int nb = gridDim.x;
#pragma unroll 1
  for (int rep = 0; rep < REP_ATT; ++rep)
  for (int it = BIDX; it < 512; it += nb) {
    const int bh = it & 7, qb = it >> 3, b = bh >> 2, h = bh & 3;
    const int mp = wid >> 2, qw = wid & 3;
    const int tok0 = b * SEQ + qb * 128 + qw * 32;
    const u16* Qlane = P.Qp() + (size_t)(tok0 + r32) * GW + h * 128 + mp * 64 + hi * 8;
    const u16* Kh = P.Kp() + (size_t)(b * SEQ) * GW + h * 128;
    const u16* Vh = P.Vp() + (size_t)(b * SEQ) * GW + h * 128;
    attn_item<true>(P, layer, Qlane, Kh, Vh, SEQ, tok0, h * 128, lam, post, lds, TIDX);
  }
  if (layer == 0) {
    for (int it = BIDX; it < 16; it += nb) { const int r = it & 7; if (it < 8) gemm_tile<2>(P, 0, (r >> 2) * 256, (r & 3) * 256, lds, TIDX); else gemm_tile<2>(P, 1, (r >> 2) * 256, (r & 3) * 256, lds, TIDX); }
  }
}

__device__ __forceinline__ constexpr float CW(int k) {
  switch (k & 31) {
    case 0: return 1.f; case 1: return 0.98078528040323043f; case 2: return 0.92387953251128674f; case 3: return 0.83146961230254524f;
    case 4: return 0.70710678118654752f; case 5: return 0.55557023301960218f; case 6: return 0.38268343236508978f; case 7: return 0.19509032201612825f;
    case 8: return 0.f; case 9: return -0.19509032201612825f; case 10: return -0.38268343236508978f; case 11: return -0.55557023301960218f;
    case 12: return -0.70710678118654752f; case 13: return -0.83146961230254524f; case 14: return -0.92387953251128674f; case 15: return -0.98078528040323043f;
    default: return -1.f; }
}
__device__ __forceinline__ constexpr float SWc(int k) {
  switch (k & 31) {
    case 0: return 0.f; case 1: return 0.19509032201612825f; case 2: return 0.38268343236508978f; case 3: return 0.55557023301960218f;
    case 4: return 0.70710678118654752f; case 5: return 0.83146961230254524f; case 6: return 0.92387953251128674f; case 7: return 0.98078528040323043f;
    case 8: return 1.f; case 9: return 0.98078528040323043f; case 10: return 0.92387953251128674f; case 11: return 0.83146961230254524f;
    case 12: return 0.70710678118654752f; case 13: return 0.55557023301960218f; case 14: return 0.38268343236508978f; case 15: return 0.19509032201612825f;
    default: return 0.f; }
}
__device__ __forceinline__ constexpr int brev5(int p) { return ((p & 1) << 4) | ((p & 2) << 2) | (p & 4) | ((p & 8) >> 2) | ((p & 16) >> 4); }
__device__ __forceinline__ int fsw(int a) { return a ^ (((a >> 5) & 15) | (((a >> 9) & 1) << 4)); }

using f2 = __attribute__((ext_vector_type(2))) float;
__device__ __forceinline__ f2 cmul_neg(f2 d, float c, float s) { return d * c + f2{d[1], -d[0]} * s; }
__device__ __forceinline__ f2 cmul_pos(f2 d, float c, float s) { return d * c + f2{-d[1], d[0]} * s; }
template <int R, bool INV, int OFF>
__device__ __forceinline__ void fft_net(f2 (&x)[32]) {
  constexpr int LOGR = (R == 32) ? 5 : 4;
  if (!INV) {
#pragma unroll
    for (int lg = LOGR - 1; lg >= 0; --lg) {
      const int h = 1 << lg;
#pragma unroll
      for (int i = 0; i < R; ++i) {
        if (i & h) continue;
        const int k = (i & (h - 1)) * (16 / h);
        const f2 a = x[OFF + i], b = x[OFF + i + h];
        x[OFF + i] = a + b;
        const f2 d = a - b;
        if (k == 0) x[OFF + i + h] = d;
        else if (k == 8) x[OFF + i + h] = f2{d[1], -d[0]};
        else x[OFF + i + h] = cmul_neg(d, CW(k), SWc(k));
      }
    }
  } else {
#pragma unroll
    for (int lg = 0; lg < LOGR; ++lg) {
      const int h = 1 << lg;
#pragma unroll
      for (int i = 0; i < R; ++i) {
        if (i & h) continue;
        const int k = (i & (h - 1)) * (16 / h);
        const f2 a = x[OFF + i], B = x[OFF + i + h];
        f2 b;
        if (k == 0) b = B;
        else if (k == 8) b = f2{-B[1], B[0]};
        else b = cmul_pos(B, CW(k), SWc(k));
        x[OFF + i] = a + b; x[OFF + i + h] = a - b;
      }
    }
  }
}
template <bool INV, int LOGN>
__device__ __forceinline__ void twiddle32(f2 (&x)[32], int j) {
  asm volatile("" : "+v"(j));
  const float turns = (float)j * (1.f / (float)(1 << LOGN));
  const float c1 = __builtin_amdgcn_cosf(turns), s1 = __builtin_amdgcn_sinf(turns);
  const f2 w2 = {c1 * c1 - s1 * s1, 2.f * c1 * s1};
  f2 we = {1.f, 0.f}, wo = {c1, s1};
#pragma unroll
  for (int r = 1; r < 32; ++r) {
    f2 w;
    if (r & 1) { w = wo; wo = cmul_pos(wo, w2[0], w2[1]); }
    else { we = cmul_pos(we, w2[0], w2[1]); w = we; }
    const int p = brev5(r);
    x[p] = INV ? cmul_pos(x[p], w[0], w[1]) : cmul_neg(x[p], w[0], w[1]);
  }
}
__device__ __forceinline__ void fft_fwd_p0(f2 (&x)[32], f2* D, int t) {
  asm volatile("" : "+v"(t));
  fft_net<32, false, 0>(x);
  twiddle32<false, 14>(x, t);
  const int e0 = t ^ ((t >> 5) & 15), e1 = e0 ^ 16;
#pragma unroll
  for (int p = 0; p < 32; ++p) D[p * 512 + ((p & 1) ? e1 : e0)] = x[p];
}
__device__ __forceinline__ void fft_fwd_p1(f2 (&x)[32], f2* D, int t) {
  asm volatile("" : "+v"(t));
  const int j = t & 15, blk = t >> 4, b0 = blk * 512 + ((blk & 1) << 4), b1 = b0 ^ 16;
#pragma unroll
  for (int q = 0; q < 32; ++q) x[q] = D[((q & 1) ? b1 : b0) + (q >> 1) * 32 + (j ^ (q >> 1))];
  fft_net<32, false, 0>(x);
  twiddle32<false, 9>(x, j);
#pragma unroll
  for (int p = 0; p < 32; ++p) D[((p & 1) ? b1 : b0) + (p >> 1) * 32 + (j ^ (p >> 1))] = x[p];
}
__device__ __forceinline__ void fft_p2_load(f2 (&x)[32], f2* D, int t) {
  asm volatile("" : "+v"(t));
#pragma unroll
  for (int u = 0; u < 2; ++u) {
    const int B = u * 512 + t, hb = (B * 16) ^ (((B >> 5) & 1) << 4), m4 = (B >> 1) & 15;
#pragma unroll
    for (int q = 0; q < 16; ++q) x[u * 16 + q] = D[hb + (q ^ m4)];
  }
  fft_net<16, false, 0>(x); fft_net<16, false, 16>(x);
}
__device__ __forceinline__ void fft_p2_inv_store(f2 (&x)[32], f2* D, int t) {
  asm volatile("" : "+v"(t));
  fft_net<16, true, 0>(x); fft_net<16, true, 16>(x);
#pragma unroll
  for (int u = 0; u < 2; ++u) {
    const int B = u * 512 + t, hb = (B * 16) ^ (((B >> 5) & 1) << 4), m4 = (B >> 1) & 15;
#pragma unroll
    for (int q = 0; q < 16; ++q) D[hb + (q ^ m4)] = x[u * 16 + q];
  }
}
__device__ __forceinline__ void fft_inv_p1(f2 (&x)[32], f2* D, int t) {
  asm volatile("" : "+v"(t));
  const int j = t & 15, blk = t >> 4, b0 = blk * 512 + ((blk & 1) << 4), b1 = b0 ^ 16;
#pragma unroll
  for (int q = 0; q < 32; ++q) x[q] = D[((q & 1) ? b1 : b0) + (q >> 1) * 32 + (j ^ (q >> 1))];
  twiddle32<true, 9>(x, j);
  fft_net<32, true, 0>(x);
#pragma unroll
  for (int p = 0; p < 32; ++p) D[((p & 1) ? b1 : b0) + (p >> 1) * 32 + (j ^ (p >> 1))] = x[p];
}
__device__ __forceinline__ void fft_inv_p0(f2 (&x)[32], f2* D, int t) {
  asm volatile("" : "+v"(t));
  const int e0 = t ^ ((t >> 5) & 15), e1 = e0 ^ 16;
#pragma unroll
  for (int q = 0; q < 32; ++q) x[q] = D[q * 512 + ((q & 1) ? e1 : e0)];
  twiddle32<true, 14>(x, t);
  fft_net<32, true, 0>(x);
}

__device__ __forceinline__ float sc_val(const u16* __restrict__ hy, int s, float w0, float w1, float w2, float bias) {
  const int sl = s > 0 ? s - 1 : 0, sr2 = s < SEQ - 1 ? s + 1 : SEQ - 1;
  const float c = bf2f(hy[s]);
  const float l = bf2f(hy[sl]) * (s > 0 ? 1.f : 0.f);
  const float r = bf2f(hy[sr2]) * (s < SEQ - 1 ? 1.f : 0.f);
  return w0 * l + w1 * c + w2 * r + bias;
}

__device__ __forceinline__ void hyena_channel(const Params& P, int layer, int c, char* lds, int TIDX, int BIDX) {
  f2* D = (f2*)lds; float* kcl = (float*)lds; float* wl = (float*)(lds + 131072);
  int t = TIDX; asm volatile("" : "+v"(t));
  const float* cw = P.conv_w + (size_t)layer * 3 * 1536; const float* cb = P.conv_b + (size_t)layer * 1536;
  const u16* hy0 = P.HYTp(); const u16* hy1 = P.HYTp() + (size_t)2048 * SEQ;
  const float min_decay = -3.0701134573253944f, max_decay = -15.350567286626972f;
  const float dF = fabsf(min_decay + (max_decay - min_decay) * ((float)c / 511.f));
  const float dB = fabsf(min_decay + (max_decay - min_decay) * ((float)(511 - c) / 511.f));
  typedef _Float16 h2_t __attribute__((ext_vector_type(2)));
  h2_t* KFH = reinterpret_cast<h2_t*>(P.Kp()) + (size_t)BIDX * 32768 + t * 32;
  {
    float* kcl1 = (float*)(lds + 65536);
    __syncthreads();
    {
      int tf = t; asm volatile("" : "+v"(tf));
      const int lane = tf & 63, r32 = lane & 31, hi = lane >> 5, wv = tf >> 6;
      bf16x8 af[4];
#pragma unroll
      for (int ks = 0; ks < 4; ++ks) {
        float wv8[8];
#pragma unroll
        for (int i = 0; i < 8; ++i) {
          const int rr = r32 & 3;
          const float x = P.hf_w4[((size_t)layer * 64 + ks * 16 + hi * 8 + i) * 2048 + (rr >> 1) * 1024 + (rr & 1) * 512 + c];
          wv8[i] = (r32 < 4) ? x : 0.f;
        }
        u32x4 w = {cvtpk(wv8[0], wv8[1]), cvtpk(wv8[2], wv8[3]), cvtpk(wv8[4], wv8[5]), cvtpk(wv8[6], wv8[7])};
        af[ks] = *reinterpret_cast<bf16x8*>(&w);
      }
      const u16* hb = reinterpret_cast<const u16*>(P.hdnp()) + ((size_t)layer * SEQ + wv * 1024 + r32) * 64 + hi * 8;
#pragma unroll 1
      for (int g = 0; g < 4; ++g) {
        bf16x8 bfr[8][4];
#pragma unroll
        for (int pb = 0; pb < 8; ++pb)
#pragma unroll
          for (int ks = 0; ks < 4; ++ks) bfr[pb][ks] = *reinterpret_cast<const bf16x8*>(hb + (size_t)((g * 8 + pb) * 32) * 64 + ks * 16);
#pragma unroll
        for (int pb = 0; pb < 8; ++pb) {
          f32x16 acc = f32x16{};
#pragma unroll
          for (int ks = 0; ks < 4; ++ks) acc = __builtin_amdgcn_mfma_f32_32x32x16_bf16(af[ks], bfr[pb][ks], acc, 0, 0, 0);
          if (hi == 0) {
            const int tt = wv * 1024 + (g * 8 + pb) * 32 + r32; const float tl = (float)tt * (1.f / 8191.f);
            const float ef = __expf(-tl * dF), eb = (tt == SEQ - 1) ? 0.f : __expf(-tl * dB);
            kcl[tt] = acc[0] * ef; kcl[16383 - tt] = acc[1] * eb;
            kcl1[tt] = acc[2] * ef; kcl1[16383 - tt] = acc[3] * eb;
          }
        }
      }
    }
    __syncthreads();
    f2 x[32];
#pragma unroll
    for (int q = 0; q < 32; ++q) x[q] = f2{kcl[q * 512 + t], kcl1[q * 512 + t]};
    __syncthreads();
    fft_fwd_p0(x, D, t); __syncthreads();
    fft_fwd_p1(x, D, t); __syncthreads();
    fft_p2_load(x, D, t);
    {
      int tx = t; asm volatile("" : "+v"(tx));
#pragma unroll
      for (int u = 0; u < 2; ++u) {
        const int B = u * 512 + tx, hb = (B * 16) ^ (((B >> 5) & 1) << 4), m4 = (B >> 1) & 15;
#pragma unroll
        for (int q = 0; q < 16; ++q) D[hb + (q ^ m4)] = x[u * 16 + q];
      }
      __syncthreads();
#pragma unroll
      for (int u = 0; u < 2; ++u)
#pragma unroll
        for (int q = 0; q < 16; ++q) {
          const unsigned a = (unsigned)((u * 512 + tx) * 16 + q);
          const unsigned kfreq = __builtin_bitreverse32(a) >> 18;
          const unsigned ap = __builtin_bitreverse32((16384u - kfreq) & 16383u) >> 18;
          const f2 v = D[fsw((int)ap)];
          const float wr = x[u * 16 + q][0], wi = x[u * 16 + q][1];
          h2_t k0 = {(_Float16)(0.5f * (wr + v[0])), (_Float16)(0.5f * (wi - v[1]))};
          h2_t k1 = {(_Float16)(0.5f * (wi + v[1])), (_Float16)(0.5f * (v[0] - wr))};
          KFH[u * 16 + q] = k0; KFH[16384 + u * 16 + q] = k1;
        }
    }
  }
  float zr[16], zi[16];
  {
    const float w0 = cw[c], w1 = cw[1536 + c], w2 = cw[3072 + c], bb = cb[c];
#pragma unroll
    for (int q = 0; q < 16; ++q) { const int s = q * 512 + t; zr[q] = sc_val(hy0 + (size_t)c * SEQ, s, w0, w1, w2, bb); zi[q] = sc_val(hy1 + (size_t)c * SEQ, s, w0, w1, w2, bb); if ((q & 3) == 3) SBAR(); }
  }
#pragma unroll 1
  for (int order = 0; order < 2; ++order) {
    const h2_t* KF = KFH + order * 16384;
    f2 x[32];
#pragma unroll
    for (int q = 0; q < 16; ++q) { x[q] = f2{zr[q], zi[q]}; x[q + 16] = f2{0.f, 0.f}; }
    __syncthreads();
    fft_fwd_p0(x, D, t); __syncthreads();
    fft_fwd_p1(x, D, t); __syncthreads();
    fft_p2_load(x, D, t);
#pragma unroll
    for (int q = 0; q < 32; ++q) { const h2_t kh = KF[q]; const float k0 = (float)kh[0] * (1.f / 16384.f), k1 = (float)kh[1] * (1.f / 16384.f); x[q] = cmul_pos(x[q], k0, k1); }
    fft_p2_inv_store(x, D, t); __syncthreads();
    fft_inv_p1(x, D, t); __syncthreads();
    fft_inv_p0(x, D, t);
    int te = t; asm volatile("" : "+v"(te));
    const float skip = P.hy_skip[((size_t)layer * 2 + order) * 512 + c];
    const int xc = (order == 0 ? 512 : 1024) + c;
    const float w0 = cw[xc], w1 = cw[1536 + xc], w2 = cw[3072 + xc], bb = cb[xc];
    if (order == 0) {
#pragma unroll
      for (int q = 0; q < 16; ++q) {
        const int s = q * 512 + te;
        const float x0 = sc_val(hy0 + (size_t)xc * SEQ, s, w0, w1, w2, bb), x1 = sc_val(hy1 + (size_t)xc * SEQ, s, w0, w1, w2, bb);
        zr[q] = x0 * (x[q][0] + skip * zr[q]); zi[q] = x1 * (x[q][1] + skip * zi[q]);
        if ((q & 3) == 3) SBAR();
      }
    } else {
#pragma unroll
      for (int q = 0; q < 16; ++q) {
        const int s = q * 512 + te;
        const float x0 = sc_val(hy0 + (size_t)xc * SEQ, s, w0, w1, w2, bb), x1 = sc_val(hy1 + (size_t)xc * SEQ, s, w0, w1, w2, bb);
        const float g0 = bf2f(hy0[(size_t)(1536 + c) * SEQ + s]), g1 = bf2f(hy1[(size_t)(1536 + c) * SEQ + s]);
        P.YBp()[(size_t)s * GW + c] = f2bf(x0 * (x[q][0] + skip * zr[q]) * silu(g0));
        P.YBp()[(size_t)(SEQ + s) * GW + c] = f2bf(x1 * (x[q][1] + skip * zi[q]) * silu(g1));
        if ((q & 3) == 3) SBAR();
      }
    }
  }
}

__device__ __forceinline__ void phase_hyena_cross(const Params& P, int layer, char* lds, int TIDX, int BIDX) {
  const int nb = gridDim.x;
#pragma unroll 1
  for (int rep = 0; rep < REP_HY; ++rep)
  for (int ci = BIDX; ci < GW; ci += nb) {
    const int c = (nb == 256) ? 64 * (BIDX & 7) + 2 * (BIDX >> 3) + (ci >> 8) : ci;
    hyena_channel(P, layer, c, lds, TIDX, BIDX);
  }
  __syncthreads();
  const int wid = TIDX >> 6, lane = TIDX & 63, r32 = lane & 31, hi = lane >> 5;
#pragma unroll 1
  for (int rep = 0; rep < REP_CROSS; ++rep)
  for (int it = BIDX; it < 256; it += nb) {
    const int h = it & 3, blk = it >> 2;
    const int tok0 = blk * 256 + wid * 32, b = tok0 >> 13;
    const u16* Qlane = P.MQp() + (size_t)(tok0 + r32) * GW + h * 128 + hi * 8;
    const u16* Kh = P.MemKVp() + ((size_t)layer * NB * MEML + b * MEML) * DM + h * 128;
    attn_item<false>(P, layer, Qlane, Kh, Kh + GW, MEML, tok0, h * 128, 0.f, 1.f, lds, TIDX);
  }
}

template <int PH>
__device__ __forceinline__ void run_phase(const Params& P, char* lds, int wave_s) {
  int TIDX = (wave_s << 6) | (int)__builtin_amdgcn_mbcnt_hi(~0u, __builtin_amdgcn_mbcnt_lo(~0u, 0u)); asm volatile("" : "+v"(TIDX));
  int BIDX = blockIdx.x; asm volatile("" : "+s"(BIDX));
  const int nb = gridDim.x, bid = BIDX;
  if constexpr (PH == 0) {
#pragma unroll 1
    for (int rep = 0; rep < REP_PREP; ++rep) phase_prep(P, lds, TIDX, BIDX); }
  else {
    constexpr int layer = (PH - 1) / 5, sub = (PH - 1) % 5;
    if constexpr (sub == 0) {
#pragma unroll 1
      for (int rep = 0; rep < REP_PROJ; ++rep)
      { bool pre = false;
        for (int it = bid; it < 64 * 20; it += nb) { const int tn = it >> 6, tm = it & 63; const int nx = it + nb; const bool hn = nx < 64 * 20;
          gemm_tile<0>(P, layer, tm * 256, tn * 256, lds, TIDX, pre, hn ? (nx & 63) * 256 : -1, hn ? (nx >> 6) * 256 : 0); pre = hn; } }
    } else if constexpr (sub == 1) {
      phase_attn(P, layer, lds, TIDX, BIDX);
    } else if constexpr (sub == 2) {
      phase_hyena_cross(P, layer, lds, TIDX, BIDX);
    } else if constexpr (sub == 3) {
#pragma unroll 1
      for (int rep = 0; rep < (layer == 0 ? REP_OUT0 : 1); ++rep)
      for (int it = bid; it < 64 * 4; it += nb) { const int tn = it >> 6, tm = it & 63; gemm_tile<1>(P, layer, tm * 256, tn * 256, lds, TIDX); }
    } else {
      const int wid = TIDX >> 6, lane = TIDX & 63;
      if constexpr (layer == 0) {
#pragma unroll 1
        for (int rep = 0; rep < REP_NORM0; ++rep)
        for (int it = bid; it < NTOK / 8; it += nb) { const int row = it * 8 + wid; norm_row_bf16(P.out + (size_t)row * DM, P.g_norm + DM, P.Hp() + (size_t)row * DM, lane); }
      } else {
        for (int it = bid; it < NTOK / 8; it += nb) { const int row = it * 8 + wid; norm_row_f32(P.out + (size_t)row * DM, P.g_final, lane); }
      }
    }
  }
}

#define XB_TMO      128
#define XB_XCNT(j)  (256  + 64 * (j))
#define XB_XSUB(j)  (1280 + 64 * (j))
#define XB_XGEN(j)  (2304 + 64 * (j))
#define XB_TOP      3328
#define XB_TOPGEN   3392
#define XCD_BAR_WORDS 3456
#define XB_SPIN_CAP (1u << 18)
#define LAS __attribute__((address_space(3)))

__device__ __forceinline__ unsigned xb_ld(unsigned* p)              { return __hip_atomic_load(p, __ATOMIC_RELAXED, __HIP_MEMORY_SCOPE_AGENT); }
__device__ __forceinline__ unsigned xb_add(unsigned* p, unsigned v) { return __hip_atomic_fetch_add(p, v, __ATOMIC_RELAXED, __HIP_MEMORY_SCOPE_AGENT); }
__device__ __forceinline__ unsigned xb_xcc_id() { return (unsigned)__builtin_amdgcn_s_getreg((3 << 11) | 20) & 0xFu; }
#define XB_SPIN(cond, bar) do { unsigned _sp = 0; while (cond) { __builtin_amdgcn_s_sleep(1); \
    if ((++_sp & 255u) == 0u) { if (xb_ld(&(bar)[XB_TMO])) break; if (_sp > XB_SPIN_CAP) { atomicAdd(&(bar)[XB_TMO], 1u); break; } } } } while (0)

struct XcdBarrier {
    unsigned* bar; unsigned x;
    volatile LAS unsigned* st;
};

__device__ __forceinline__ XcdBarrier xcd_barrier_post(unsigned* bar, volatile LAS unsigned* st) {
    XcdBarrier b; b.bar = bar; b.x = xb_xcc_id(); b.st = st;
    if (threadIdx.x == 0) (void)xb_add(&bar[XB_XCNT(b.x)], 1u);
    return b;
}
__device__ __forceinline__ void xcd_barrier_complete(unsigned* bar, unsigned x, unsigned& nloc, unsigned& nx) {
    const unsigned G = gridDim.x * gridDim.y * gridDim.z;
    unsigned sum, cnt, mine, sp = 0u;
    for (;;) {
        sum = 0u; cnt = 0u; mine = 0u;
#pragma unroll
        for (unsigned j = 0; j < 16; ++j) { const unsigned c = xb_ld(&bar[XB_XCNT(j)]); sum += c; cnt += (c > 0u) ? 1u : 0u; mine = (j == x) ? c : mine; }
        if (sum == G) break;
        __builtin_amdgcn_s_sleep(1);
        if ((++sp & 255u) == 0u) { if (xb_ld(&bar[XB_TMO])) break; if (sp > XB_SPIN_CAP) { atomicAdd(&bar[XB_TMO], 1u); break; } }
    }
    nloc = mine > 0u ? mine : 1u; nx = cnt > 0u ? cnt : 1u;
}

__device__ __forceinline__ void xcd_barrier(const XcdBarrier& b) {
    asm volatile("s_waitcnt vmcnt(0)" ::: "memory");
    __syncthreads();
    if (threadIdx.x == 0) {
        unsigned* bar = b.bar;
        __builtin_amdgcn_s_waitcnt(0);
        unsigned nloc = b.st[0], nx = b.st[1];
        if (nloc == 0u) { xcd_barrier_complete(bar, b.x, nloc, nx); b.st[0] = nloc; b.st[1] = nx; }
        const unsigned old = xb_add(&bar[XB_XSUB(b.x)], 1u);
        const unsigned gen = old / nloc;
        if (old + 1u == (gen + 1u) * nloc) {
            __builtin_amdgcn_fence(__ATOMIC_RELEASE, "agent");
            asm volatile("s_waitcnt vmcnt(0)" ::: "memory");
            const unsigned og = xb_add(&bar[XB_TOP], 1u);
            const unsigned tg = og / nx;
            if (og + 1u == (tg + 1u) * nx) xb_add(&bar[XB_TOPGEN], 1u);
            else XB_SPIN(xb_ld(&bar[XB_TOPGEN]) == tg, bar);
            __builtin_amdgcn_fence(__ATOMIC_ACQUIRE, "agent");
            xb_add(&bar[XB_XGEN(b.x)], 1u);
            asm volatile("s_waitcnt vmcnt(0)" ::: "memory");
        } else {
            XB_SPIN(xb_ld(&bar[XB_XGEN(b.x)]) == gen, bar);
            __builtin_amdgcn_fence(__ATOMIC_ACQUIRE, "agent");
            asm volatile("s_waitcnt vmcnt(0)" ::: "memory");
        }
    }
    __syncthreads();
}

template <bool SINGLE>
__global__ __launch_bounds__(512) void mega(Params P) {
  extern __shared__ __attribute__((aligned(16))) char lds[];
  const int wave_s = __builtin_amdgcn_readfirstlane((int)threadIdx.x >> 6);
  if constexpr (SINGLE) {
    cg::grid_group grid = cg::this_grid();
    __shared__ unsigned xb_st[4];
    if (threadIdx.x < 4) xb_st[threadIdx.x] = 0u;
    __syncthreads();
    const XcdBarrier xb = xcd_barrier_post((unsigned*)(P.ws + (size_t)232 * 1048576), (volatile LAS unsigned*)xb_st);
    if (P.phase_hi < 0) grid.sync();
    run_phase<0>(P, lds, wave_s); xcd_barrier(xb);
    run_phase<1>(P, lds, wave_s); xcd_barrier(xb);
    run_phase<2>(P, lds, wave_s); xcd_barrier(xb);
    run_phase<3>(P, lds, wave_s); xcd_barrier(xb);
    run_phase<4>(P, lds, wave_s); xcd_barrier(xb);
    run_phase<5>(P, lds, wave_s); xcd_barrier(xb);
    run_phase<6>(P, lds, wave_s); xcd_barrier(xb);
    run_phase<7>(P, lds, wave_s); xcd_barrier(xb);
    run_phase<8>(P, lds, wave_s); xcd_barrier(xb);
    run_phase<9>(P, lds, wave_s); xcd_barrier(xb);
    run_phase<10>(P, lds, wave_s);
  } else {
    switch (P.phase_lo) {
      case 0: run_phase<0>(P, lds, wave_s); break;
      case 1: run_phase<1>(P, lds, wave_s); break;
      case 2: run_phase<2>(P, lds, wave_s); break;
      case 3: run_phase<3>(P, lds, wave_s); break;
      case 4: run_phase<4>(P, lds, wave_s); break;
      case 5: run_phase<5>(P, lds, wave_s); break;
      case 6: run_phase<6>(P, lds, wave_s); break;
      case 7: run_phase<7>(P, lds, wave_s); break;
      case 8: run_phase<8>(P, lds, wave_s); break;
      case 9: run_phase<9>(P, lds, wave_s); break;
      default: run_phase<10>(P, lds, wave_s); break;
    }
  }
}

extern "C" void kernel_launch(void* const* d_in, const int* in_sizes, int n_in, void* d_out, int out_size, void* d_ws, size_t ws_size, hipStream_t stream) {
  static int grid = 0;
  if (grid == 0) {
    int dev = 0, cus = 0, per_cu = 0;
    hipGetDevice(&dev);
    hipDeviceGetAttribute(&cus, hipDeviceAttributeMultiprocessorCount, dev);
    if (hipFuncSetAttribute((const void*)MEGA, hipFuncAttributeMaxDynamicSharedMemorySize, LDS_BYTES) != hipSuccess) { fprintf(stderr, "hipFuncSetAttribute failed\n"); grid = -1; return; }
    hipOccupancyMaxActiveBlocksPerMultiprocessor(&per_cu, (const void*)MEGA, 512, LDS_BYTES);
    (void)hipGetLastError();
    (void)per_cu;
    grid = cus < 256 ? cus : 256;
  }
  if (grid < 0) return;
  Params p{};
  const float** f = (const float**)&p.x;
  for (int i = 0; i < 24; ++i) f[i] = (const float*)d_in[i];
  p.out = (float*)d_out;
  p.ws = (char*)d_ws;
#if ONE_LAUNCH
  p.phase_lo = 0; p.phase_hi = NPHASE;
  hipMemsetAsync((char*)d_ws + (size_t)232 * 1048576, 0, 16384, stream);
  void* args[] = {&p};
  hipError_t e = hipLaunchCooperativeKernel((const void*)MEGA, dim3(grid), dim3(512), args, LDS_BYTES, stream);
  if (e != hipSuccess) fprintf(stderr, "cooperative launch failed: %s (grid %d)\n", hipGetErrorString(e), grid);
#else
  for (int ph = 0; ph < NPHASE; ++ph) {
    p.phase_lo = ph; p.phase_hi = ph + 1;
    hipLaunchKernelGGL(MEGA, dim3(grid), dim3(512), LDS_BYTES, stream, p);
  }
#endif
}
```
